# Optimizing an MI355X kernel written in HIP

```python
import jax
import jax.numpy as jnp
from jax import lax
import numpy as np

D_MODEL = 1024
BATCH = 16
SEQ = 2048
DEPTH = 1

GRID_W = 64
CTX_LEN = 256
N_HEADS_NA = 8
HEAD_DIM_NA = 64
WIN_H = 8
WIN_W = 16
NA_QCOLS = 16
NA_KCOLS = 32
N_HEADS_MLA = 8
MLA_Q_RANK = 768
MLA_KV_RANK = 256
MLA_NOPE_DIM = 64
MLA_ROPE_DIM = 32
MLA_V_DIM = 64
D_FF = 2816
ROPE_BASE = 10000.0
RMS_EPS = 1e-6
ATTN_QBLOCK = 128
N_MOD = 9
HALF_STEP = 0.5
NA_WIDTH = N_HEADS_NA * HEAD_DIM_NA
MLA_QK_DIM = MLA_NOPE_DIM + MLA_ROPE_DIM
IN_SPLITS = (NA_WIDTH, 2 * NA_WIDTH, 3 * NA_WIDTH, 3 * NA_WIDTH + MLA_Q_RANK,
             3 * NA_WIDTH + MLA_Q_RANK + MLA_KV_RANK,
             3 * NA_WIDTH + MLA_Q_RANK + MLA_KV_RANK + MLA_ROPE_DIM)
IN_COLS = IN_SPLITS[-1] + 2 * D_MODEL

kernel_name = 'hybrid_natten_mla_macaron_block'


def _rmsnorm(x, g):
    x32 = x.astype(jnp.float32)
    y = x32 * lax.rsqrt(jnp.mean(x32 * x32, axis=-1, keepdims=True) + RMS_EPS)
    return y.astype(x.dtype) * g


def _modnorm(x, g_pre, shift, scale):
    return _rmsnorm(x, g_pre) * (1 + scale) + shift


def _residual(x, y, g_post, gate, weight):
    return x + weight * gate * _rmsnorm(y, g_post)


def _swiglu(h, w1, w3, w2):
    return (jax.nn.silu(h @ w1) * (h @ w3)) @ w2


def _axial_angles(n_tokens):
    half = MLA_ROPE_DIM // 4
    freqs = ROPE_BASE ** (-jnp.arange(half, dtype=jnp.float32) / half)
    t = jnp.arange(n_tokens)
    rows = (t // GRID_W).astype(jnp.float32)
    cols = (t % GRID_W).astype(jnp.float32)
    return rows[:, None] * freqs, cols[:, None] * freqs


def _rope_axis(x, ang):
    half = x.shape[-1] // 2
    cos = jnp.cos(ang)[None, :, None, :].astype(x.dtype)
    sin = jnp.sin(ang)[None, :, None, :].astype(x.dtype)
    x1, x2 = x[..., :half], x[..., half:]
    return jnp.concatenate([x1 * cos - x2 * sin, x2 * cos + x1 * sin], axis=-1)


def _axial_rope(x, ang_r, ang_c):
    a = MLA_ROPE_DIM // 2
    return jnp.concatenate([_rope_axis(x[..., :a], ang_r), _rope_axis(x[..., a:], ang_c)], axis=-1)


def _project(h, w_in, b_gate, g_q, g_kv, w_uq, w_ukv):
    B, T, _ = h.shape
    qa, ka, va, cq, ckv, kr, gates = jnp.split(h @ w_in, IN_SPLITS, axis=-1)
    heads = lambda t, n: t.reshape(B, T, n, -1)
    q = heads(_rmsnorm(cq, g_q) @ w_uq, N_HEADS_MLA)
    kv = heads(_rmsnorm(ckv, g_kv) @ w_ukv, N_HEADS_MLA)
    g = jax.nn.sigmoid(gates + b_gate)
    return (heads(qa, N_HEADS_NA), heads(ka, N_HEADS_NA), heads(va, N_HEADS_NA),
            q[..., :MLA_NOPE_DIM], q[..., MLA_NOPE_DIM:],
            kv[..., :MLA_NOPE_DIM], kr[:, :, None, :], kv[..., MLA_NOPE_DIM:],
            g[..., :D_MODEL], g[..., D_MODEL:])


def _mla_q(q_nope, q_rope):
    return jnp.concatenate([q_nope, q_rope], axis=-1)


def _mla_k(k_nope, k_rope):
    k_rope = jnp.broadcast_to(k_rope, k_nope.shape[:-1] + (k_rope.shape[-1],))
    return jnp.concatenate([k_nope, k_rope], axis=-1)


def _attend(q, k, v):
    s = jnp.einsum('bqhd,bkhd->bhqk', q * q.shape[-1] ** -0.5, k).astype(jnp.float32)
    p = jax.nn.softmax(s, axis=-1).astype(v.dtype)
    return jnp.einsum('bhqk,bkhd->bqhd', p, v)


def _blocked_attention(q, k, v):
    B, S, H, dq = q.shape
    qb = q.reshape(B, S // ATTN_QBLOCK, ATTN_QBLOCK, H, dq).swapaxes(0, 1)
    out = lax.map(lambda qq: _attend(qq, k, v), qb)
    return out.swapaxes(0, 1).reshape(B, S, H, v.shape[-1])


def _na_column_tables():
    n_blk = GRID_W // NA_QCOLS
    j = np.arange(n_blk)
    k_start = np.clip(j * NA_QCOLS - WIN_W // 2, 0, GRID_W - NA_KCOLS)
    key_col = k_start[:, None] + np.arange(NA_KCOLS)
    q_col = j[:, None] * NA_QCOLS + np.arange(NA_QCOLS)
    w_start = np.clip(q_col - WIN_W // 2, 0, GRID_W - WIN_W)
    kc = key_col[:, None, :]
    valid = (kc >= w_start[..., None]) & (kc < w_start[..., None] + WIN_W)
    off = np.clip(kc - q_col[..., None], -(WIN_W - 1), WIN_W - 1) + (WIN_W - 1)
    return jnp.asarray(key_col, jnp.int32), jnp.asarray(valid), jnp.asarray(off, jnp.int32)


def _neighbourhood_attention(q, k, v, k_ctx, v_ctx, rpb, n_rows):
    B, S, H, d = q.shape
    kh = min(WIN_H, n_rows)
    n_blk = GRID_W // NA_QCOLS
    n_loc = kh * NA_KCOLS
    key_col, valid, col_off = _na_column_tables()
    grid = lambda t: t.reshape(B, n_rows, GRID_W, H, t.shape[-1])
    qg, kg, vg = grid(q * d ** -0.5), grid(k), grid(v)
    neg = jnp.finfo(jnp.float32).min

    def row(r):
        rs = jnp.clip(r - kh // 2, 0, n_rows - kh)
        q_r = lax.dynamic_index_in_dim(qg, r, axis=1, keepdims=False).reshape(B, n_blk, NA_QCOLS, H, d)
        k_b = jnp.moveaxis(lax.dynamic_slice_in_dim(kg, rs, kh, axis=1)[:, :, key_col], 2, 1)
        v_b = jnp.moveaxis(lax.dynamic_slice_in_dim(vg, rs, kh, axis=1)[:, :, key_col], 2, 1)
        row_off = rs + jnp.arange(kh) - r + (WIN_H - 1)
        bias = rpb[:, row_off[None, None, :, None], col_off[:, :, None, :]]
        s_loc = jnp.einsum('bjqhd,bjakhd->bhjqak', q_r, k_b).astype(jnp.float32) + bias.astype(jnp.float32)
        s_loc = jnp.where(valid[:, :, None, :], s_loc, neg).reshape(B, H, n_blk, NA_QCOLS, n_loc)
        s_ctx = jnp.einsum('bjqhd,bkhd->bhjqk', q_r, k_ctx).astype(jnp.float32)
        p = jax.nn.softmax(jnp.concatenate([s_loc, s_ctx], axis=-1), axis=-1).astype(v.dtype)
        p_loc = p[..., :n_loc].reshape(B, H, n_blk, NA_QCOLS, kh, NA_KCOLS)
        o = (jnp.einsum('bhjqak,bjakhd->bjqhd', p_loc, v_b)
             + jnp.einsum('bhjqk,bkhd->bjqhd', p[..., n_loc:], v_ctx))
        return o.reshape(B, GRID_W, H, v.shape[-1])

    out = lax.map(row, jnp.arange(n_rows))
    return jnp.moveaxis(out, 0, 1).reshape(B, S, H, v.shape[-1])


def _merge(o_na, o_mla, g_na, g_mla, w_o_na, w_o_mla, w_out):
    B, T = o_na.shape[:2]
    y = g_na * (o_na.reshape(B, T, -1) @ w_o_na) + g_mla * (o_mla.reshape(B, T, -1) @ w_o_mla)
    return y @ w_out


def setup_inputs(seed: int = 0) -> dict:
    key = jax.random.key(seed)
    ks = jax.random.split(key, 24)
    nrm = lambda k, shape, s: jax.random.normal(k, shape, jnp.float32) * s
    D = D_MODEL
    return {
        'x': nrm(ks[0], (BATCH, SEQ, D), 1.0),
        'c': nrm(ks[1], (BATCH, D), 1.0),
        'ctx': nrm(ks[2], (BATCH, CTX_LEN, D), 1.0),
        'c_ctx': nrm(ks[3], (D,), 1.0),
        'w_ada': nrm(ks[4], (DEPTH, D, N_MOD * D), 0.5 * D ** -0.5),
        'b_ada': nrm(ks[5], (DEPTH, N_MOD * D), 0.02),
        'norm_g': 1.0 + nrm(ks[6], (DEPTH, 6, D), 0.02),
        'ffn1_w1': nrm(ks[7], (DEPTH, D, D_FF), D ** -0.5),
        'ffn1_w3': nrm(ks[8], (DEPTH, D, D_FF), D ** -0.5),
        'ffn1_w2': nrm(ks[9], (DEPTH, D_FF, D), D_FF ** -0.5),
        'w_in': nrm(ks[10], (DEPTH, D, IN_COLS), D ** -0.5),
        'b_gate': nrm(ks[11], (DEPTH, 2 * D), 0.1),
        'g_q_lora': 1.0 + nrm(ks[12], (DEPTH, MLA_Q_RANK), 0.02),
        'g_kv_lora': 1.0 + nrm(ks[13], (DEPTH, MLA_KV_RANK), 0.02),
        'w_uq': nrm(ks[14], (DEPTH, MLA_Q_RANK, N_HEADS_MLA * MLA_QK_DIM), MLA_Q_RANK ** -0.5),
        'w_ukv': nrm(ks[15], (DEPTH, MLA_KV_RANK, N_HEADS_MLA * (MLA_NOPE_DIM + MLA_V_DIM)), MLA_KV_RANK ** -0.5),
        'rpb': nrm(ks[16], (DEPTH, N_HEADS_NA, 2 * WIN_H - 1, 2 * WIN_W - 1), 0.1),
        'w_o_na': nrm(ks[17], (DEPTH, NA_WIDTH, D), NA_WIDTH ** -0.5),
        'w_o_mla': nrm(ks[18], (DEPTH, N_HEADS_MLA * MLA_V_DIM, D), (N_HEADS_MLA * MLA_V_DIM) ** -0.5),
        'w_out': nrm(ks[19], (DEPTH, D, D), D ** -0.5),
        'ffn2_w1': nrm(ks[20], (DEPTH, D, D_FF), D ** -0.5),
        'ffn2_w3': nrm(ks[21], (DEPTH, D, D_FF), D ** -0.5),
        'ffn2_w2': nrm(ks[22], (DEPTH, D_FF, D), D_FF ** -0.5),
    }


def reference(x, c, ctx, c_ctx, w_ada, b_ada, norm_g, ffn1_w1, ffn1_w3, ffn1_w2, w_in, b_gate,
              g_q_lora, g_kv_lora, w_uq, w_ukv, rpb, w_o_na, w_o_mla, w_out, ffn2_w1, ffn2_w3, ffn2_w2):
    n_lat = x.shape[1]
    n_rows = n_lat // GRID_W
    ang_r, ang_c = _axial_angles(n_lat)
    h_ctx = ctx
    for l in range(DEPTH):
        last = l == DEPTH - 1
        m = jnp.split((jax.nn.silu(c) @ w_ada[l] + b_ada[l])[:, None, :], N_MOD, axis=-1)
        mc = jnp.split(jax.nn.silu(c_ctx) @ w_ada[l] + b_ada[l], N_MOD, axis=-1)
        g = norm_g[l]
        x = _residual(x, _swiglu(_modnorm(x, g[0], m[0], m[1]), ffn1_w1[l], ffn1_w3[l], ffn1_w2[l]),
                      g[1], m[2], HALF_STEP)
        h_ctx = _residual(h_ctx, _swiglu(_modnorm(h_ctx, g[0], mc[0], mc[1]), ffn1_w1[l], ffn1_w3[l], ffn1_w2[l]),
                          g[1], mc[2], HALF_STEP)
        pw = (w_in[l], b_gate[l], g_q_lora[l], g_kv_lora[l], w_uq[l], w_ukv[l])
        qa, ka, va, qn, qr, kn, kr, vb, ga, gb = _project(_modnorm(x, g[2], m[3], m[4]), *pw)
        cqa, cka, cva, cqn, cqr, ckn, ckr, cvb, cga, cgb = _project(_modnorm(h_ctx, g[2], mc[3], mc[4]), *pw)
        o_na = _neighbourhood_attention(qa, ka, va, cka, cva, rpb[l], n_rows)
        k_ctx_mla = _mla_k(ckn, ckr)
        q_mla = _mla_q(qn, _axial_rope(qr, ang_r, ang_c))
        k_mla = jnp.concatenate([k_ctx_mla, _mla_k(kn, _axial_rope(kr, ang_r, ang_c))], axis=1)
        v_mla = jnp.concatenate([cvb, vb], axis=1)
        o_mla = _blocked_attention(q_mla, k_mla, v_mla)
        y = _merge(o_na, o_mla, ga, gb, w_o_na[l], w_o_mla[l], w_out[l])
        x = _residual(x, y, g[3], m[5], 1.0)
        if not last:
            yc = _merge(_attend(cqa, cka, cva), _attend(_mla_q(cqn, cqr), k_ctx_mla, cvb),
                        cga, cgb, w_o_na[l], w_o_mla[l], w_out[l])
            h_ctx = _residual(h_ctx, yc, g[3], mc[5], 1.0)
            h_ctx = _residual(h_ctx, _swiglu(_modnorm(h_ctx, g[4], mc[6], mc[7]), ffn2_w1[l], ffn2_w3[l], ffn2_w2[l]),
                              g[5], mc[8], HALF_STEP)
        x = _residual(x, _swiglu(_modnorm(x, g[4], m[6], m[7]), ffn2_w1[l], ffn2_w3[l], ffn2_w2[l]),
                      g[5], m[8], HALF_STEP)
    return x
```

```cpp
#include <hip/hip_runtime.h>
#include <hip/hip_cooperative_groups.h>
#include <cstdint>
#include <cstdio>
namespace cg = cooperative_groups;

typedef unsigned short bf16_t;
typedef short bf16x8 __attribute__((ext_vector_type(8)));
typedef short s16x4 __attribute__((ext_vector_type(4)));
typedef float f32x4 __attribute__((ext_vector_type(4)));
typedef float f32x2 __attribute__((ext_vector_type(2)));
typedef unsigned u32x4 __attribute__((ext_vector_type(4)));
typedef unsigned u32x2 __attribute__((ext_vector_type(2)));
typedef __bf16 bf2_t __attribute__((ext_vector_type(2)));

#define DI __device__ __forceinline__

constexpr int NT = 512;
constexpr int NW = 8;
constexpr int TL = 32768;
constexpr int TC = 4096;
constexpr int TA = 36864;
constexpr int DFF = 2816;
constexpr int NPROJ = 4640;
constexpr int NPROJP = 4864;
constexpr int LDT = 72;
constexpr int LDV = 80;
constexpr int LDK = 104;
constexpr int LDS_BYTES = (256 + 576 + 256) * LDT * 2;
static_assert(LDS_BYTES >= 131072, "GEMM stage ring");
constexpr float RMS_EPS = 1e-6f;
constexpr float LOG2E = 1.4426950408889634f;

struct Params {
  const float *x, *c, *ctx, *c_ctx, *w_ada, *b_ada, *norm_g, *f1w1, *f1w3, *f1w2, *w_in, *b_gate, *g_q, *g_kv,
      *w_uq, *w_ukv, *rpb, *w_o_na, *w_o_mla, *w_out, *f2w1, *f2w3, *f2w2;
  float* out;
  long never;
  unsigned* bar;
  float* mod;
  float* ropecs;
  float* ssq;
  bf16_t *W13a, *W2a, *Win, *Wuq, *Wukv, *Wona, *Womla, *Wout, *W13b, *W2b;
  float* xc;
  float* yc1;
  bf16_t* H;
  bf16_t* big;
};

constexpr size_t OFF_U = 0;
constexpr size_t OFF_Y = (size_t)TA * DFF;
constexpr size_t OFF_QA = 0;
constexpr size_t OFF_KA = OFF_QA + (size_t)TL * 512;
constexpr size_t OFF_VA = OFF_KA + (size_t)TA * 512;
constexpr size_t OFF_CQ = OFF_VA + (size_t)TA * 512;
constexpr size_t OFF_CKV = OFF_CQ + (size_t)TL * 768;
constexpr size_t OFF_KR = OFF_CKV + (size_t)TA * 256;
constexpr size_t OFF_G = OFF_KR + (size_t)TA * 32;
constexpr size_t OFF_QM = OFF_G + (size_t)TL * 2048;
constexpr size_t BIG_ELEMS = OFF_QM + (size_t)TL * 768;
constexpr size_t OFF_OM = OFF_CQ;
constexpr size_t OFF_ON = OFF_OM + (size_t)TL * 512;
static_assert(OFF_ON + (size_t)TL * 512 <= OFF_KR, "NA output must fit before KR");
constexpr size_t OFF_Y2 = OFF_KA;

DI int ltid() { int t = threadIdx.x; asm volatile("" : "+v"(t)); return t; }
DI unsigned pk_bf16(float lo, float hi) {
  f32x2 v = {lo, hi};
  bf2_t r = __builtin_convertvector(v, bf2_t);
  return __builtin_bit_cast(unsigned, r);
}
DI void store_bf16x4(bf16_t* p, f32x4 v) {
  u32x2 w; w.x = pk_bf16(v[0], v[1]); w.y = pk_bf16(v[2], v[3]);
  *(u32x2*)p = w;
}
DI f32x4 load_bf16x4(const bf16_t* p) {
  const u32x2 w = *(const u32x2*)p;
  return (f32x4){__uint_as_float(w.x << 16), __uint_as_float(w.x & 0xffff0000u), __uint_as_float(w.y << 16), __uint_as_float(w.y & 0xffff0000u)};
}
DI f32x4 mfma16(bf16x8 a, bf16x8 b, f32x4 c) { return __builtin_amdgcn_mfma_f32_16x16x32_bf16(a, b, c, 0, 0, 0); }
DI s16x4 tr_read(const bf16_t* p) {
  return __builtin_amdgcn_ds_read_tr16_b64_v4i16((__attribute__((address_space(3))) s16x4*)p);
}
DI bf16x8 cat8(s16x4 lo, s16x4 hi) { return __builtin_shufflevector(lo, hi, 0, 1, 2, 3, 4, 5, 6, 7); }
DI float wave_sum(float v) {
  v += __shfl_xor(v, 32); v += __shfl_xor(v, 16); v += __shfl_xor(v, 8);
  v += __shfl_xor(v, 4); v += __shfl_xor(v, 2); v += __shfl_xor(v, 1);
  return v;
}

DI f32x4 rope4(f32x4 v, int fq, int pos, const float* ropecs) {
  f32x4 o;
#pragma unroll
  for (int j = 0; j < 4; ++j) {
    const float other = __shfl_xor(v[j], 32);
    const int i = (4 * fq + j) & 7;
    const float cs = ropecs[pos * 8 + i], sn = ropecs[512 + pos * 8 + i];
    o[j] = (fq < 2) ? (v[j] * cs - other * sn) : (v[j] * cs + other * sn);
  }
  return o;
}

DI f32x4 rope4p(f32x4 v, int n, int fq, int pos_row, int pos_col, const float* ropecs) {
  const int pos = (fq >> 1) ? pos_col : pos_row;
  f32x4 o;
#pragma unroll
  for (int j = 0; j < 4; ++j) {
    const float other = __shfl_xor(v[j], 16);
    const int i = 4 * n + j;
    const float cs = ropecs[pos * 8 + i], sn = ropecs[512 + pos * 8 + i];
    o[j] = ((fq & 1) == 0) ? (v[j] * cs - other * sn) : (v[j] * cs + other * sn);
  }
  return o;
}
DI void store_bf16x8(bf16_t* p, f32x4 a, f32x4 b) {
  u32x4 w; w.x = pk_bf16(a[0], a[1]); w.y = pk_bf16(a[2], a[3]); w.z = pk_bf16(b[0], b[1]); w.w = pk_bf16(b[2], b[3]);
  *(u32x4*)p = w;
}
DI void load_bf16x8(const bf16_t* p, f32x4& a, f32x4& b) {
  const u32x4 w = *(const u32x4*)p;
  a = (f32x4){__uint_as_float(w.x << 16), __uint_as_float(w.x & 0xffff0000u), __uint_as_float(w.y << 16), __uint_as_float(w.y & 0xffff0000u)};
  b = (f32x4){__uint_as_float(w.z << 16), __uint_as_float(w.z & 0xffff0000u), __uint_as_float(w.w << 16), __uint_as_float(w.w & 0xffff0000u)};
}

#ifndef WGM_UP
#define WGM_UP 2
#endif
#ifndef WGM_N4
#define WGM_N4 2
#endif
#ifndef WGM_PROJ
#define WGM_PROJ 4
#endif
namespace pg8 {
#define PG8_LAS __attribute__((address_space(3)))
constexpr int BM = 256, BK = 64, HALF = 128, HTB = HALF * BK * 2, STAGE_BYTES = 8 * HTB, NXCD = 8, WGM = 4;
__host__ __device__ __forceinline__ int lds_byte(int r, int c) { const int st = (r >> 4) * 2 + (c >> 5), rr = r & 15, cc = c & 31, ob = rr * 64 + cc * 2; return st * 1024 + (ob ^ (((ob >> 9) & 1) << 5)); }
__host__ __device__ __forceinline__ void stage_rc(int b, int& R, int& C) { const int st = b / 1024, sb = b % 1024, swz = sb ^ (((sb >> 9) & 1) << 5); R = (st >> 1) * 16 + swz / 64; C = (st & 1) * 32 + (swz % 64) / 2; }
__host__ __device__ __forceinline__ int perm32(int rho) { const int n = rho >> 4, i = rho & 15; return 8 * (i >> 2) + 4 * n + (i & 3); }

struct Unit { int pm, pn; };
struct Gemm { const bf16_t* A; const bf16_t* Bt; int M, N, K; int lda = 0, ldb = 0; };

struct StaticOrder {
    int nM, nN, nwg, G, c, wgm = WGM;
    __host__ __device__ void init(int M, int N, int G_, int c_) { nM = M / BM; nN = N / BM; nwg = nM * nN; G = G_; c = c_; }
    __host__ __device__ bool next(int i, Unit& u) const {
        const long L = (long)i * G + c; if (L >= nwg) return false;
        int wgid = (int)L; { const int q = nwg / NXCD, r = nwg % NXCD, xcd = wgid % NXCD, off = wgid / NXCD; wgid = (xcd < r ? xcd * (q + 1) : r * (q + 1) + (xcd - r) * q) + off; }
        const int nig = wgm * nN, gid = wgid / nig, fm = gid * wgm, gsz = (nM - fm) < wgm ? (nM - fm) : wgm;
        u.pm = fm + ((wgid % nig) % gsz); u.pn = (wgid % nig) / gsz; return true;
    }
    __device__ __forceinline__ void a_ready(const Unit&) const {}
    __device__ __forceinline__ void done(const Unit&) const {}
};
template <class Epi, class Sched, bool ALIGN_EPI = true, bool SP2 = true>
__device__ __forceinline__ void gemm_phase(PG8_LAS unsigned char* lds, const Gemm g, const Sched& S, const Epi& E) {
    int tid = threadIdx.x; asm volatile("" : "+v"(tid));
    const int wid = __builtin_amdgcn_readfirstlane(tid >> 6), lane = tid & 63, wr = wid >> 2, wc = wid & 3, fr = lane & 15, fq = lane >> 4;
    int K = g.K; asm volatile("" : "+s"(K)); const int nt = K / BK;
    int lda = g.lda ? g.lda : g.K, ldb = g.ldb ? g.ldb : g.K; asm volatile("" : "+s"(lda), "+s"(ldb));
    unsigned voffA[2], voffB[2];
#pragma unroll
    for (int i = 0; i < 2; ++i) { int R, C; stage_rc(tid * 16 + i * 8192, R, C); const int Rb = Epi::PERM ? ((R & ~31) + perm32(R & 31)) : R;
        voffA[i] = (unsigned)(R * lda + C) * 2u; voffB[i] = (unsigned)(Rb * ldb + C) * 2u; }
    const size_t kstep = (size_t)(BK * 2);
    const size_t hstepA = (size_t)HALF * lda * 2, hstepB = (size_t)HALF * ldb * 2;
    const size_t tstepA = 2 * hstepA, tstepB = 2 * hstepB;
    const unsigned ldsw = (unsigned)wid * 1024u;
    const int aoff = lds_byte(wr * 64 + fr, fq * 8), boff = lds_byte(wc * 32 + fr, fq * 8);
#define PG8_SA(b, h) (((b) * 2 + (h)) * HTB)
#define PG8_SB(b, h) ((4 + (b) * 2 + (h)) * HTB)
#define PG8_STAGE(bufoff, gbase, voff) do { _Pragma("unroll") for (int _i = 0; _i < 2; ++_i) \
        __builtin_amdgcn_global_load_lds((const unsigned*)((const char*)(gbase) + (voff)[_i]), (PG8_LAS unsigned*)(lds + (bufoff) + ldsw + _i * 8192), 16, 0, 0); } while (0)
#define PG8_LDA(dst, b, h) do { _Pragma("unroll") for (int m = 0; m < 4; ++m) _Pragma("unroll") for (int k = 0; k < 2; ++k) dst[m][k] = *(const PG8_LAS bf16x8*)(lds + PG8_SA(b, h) + aoff + m * 2048 + k * 1024); } while (0)
#define PG8_LDB(dst, b, h) do { _Pragma("unroll") for (int n = 0; n < 2; ++n) _Pragma("unroll") for (int k = 0; k < 2; ++k) dst[n][k] = *(const PG8_LAS bf16x8*)(lds + PG8_SB(b, h) + boff + n * 2048 + k * 1024); } while (0)
#define PG8_MMA(ai, bj, At, Bt) do { __builtin_amdgcn_s_setprio(1); _Pragma("unroll") for (int m = 0; m < 4; ++m) _Pragma("unroll") for (int n = 0; n < 2; ++n) _Pragma("unroll") for (int k = 0; k < 2; ++k) \
        acc[ai][bj][m][n] = __builtin_amdgcn_mfma_f32_16x16x32_bf16(Bt[n][k], At[m][k], acc[ai][bj][m][n], 0, 0, 0); __builtin_amdgcn_s_setprio(0); } while (0)
#define PG8_WAIT_V(n) asm volatile("s_waitcnt vmcnt(" #n ")" ::: "memory")
#define PG8_WAIT_L(n) asm volatile("s_waitcnt lgkmcnt(" #n ")" ::: "memory")
#define PG8_BAR __builtin_amdgcn_s_barrier()
#define PG8_SCHED __builtin_amdgcn_sched_barrier(0)
    Unit cur, nxt; int ui = 0;
    if (!S.next(0, cur)) return;
    f32x4 acc[2][2][4][2];
#pragma unroll
    for (int a = 0; a < 2; ++a)
#pragma unroll
        for (int b = 0; b < 2; ++b)
#pragma unroll
            for (int m = 0; m < 4; ++m)
#pragma unroll
                for (int n = 0; n < 2; ++n) acc[a][b][m][n] = (f32x4){0.f, 0.f, 0.f, 0.f};
    bf16x8 At[4][2], B0[2][2], B1[2][2];
    const char* cA = (const char*)g.A + (size_t)cur.pm * tstepA; const char* cB = (const char*)g.Bt + (size_t)cur.pn * tstepB;
    S.a_ready(cur);
    if constexpr (SP2) {
        PG8_STAGE(PG8_SB(0, 0), cB, voffB); PG8_STAGE(PG8_SB(0, 1), cB + hstepB, voffB); PG8_STAGE(PG8_SA(0, 0), cA, voffA); PG8_STAGE(PG8_SA(0, 1), cA + hstepA, voffA);
        if (wr == 1) PG8_BAR;
        PG8_WAIT_V(2); PG8_BAR;
        PG8_STAGE(PG8_SB(1, 0), cB + kstep, voffB); PG8_STAGE(PG8_SA(1, 0), cA + kstep, voffA); PG8_STAGE(PG8_SB(1, 1), cB + hstepB + kstep, voffB);
        PG8_WAIT_V(6); PG8_BAR;
    } else {
        PG8_STAGE(PG8_SB(0, 0), cB, voffB); PG8_STAGE(PG8_SA(0, 0), cA, voffA); PG8_STAGE(PG8_SB(0, 1), cB + hstepB, voffB); PG8_STAGE(PG8_SA(0, 1), cA + hstepA, voffA);
        if (wr == 1) PG8_BAR;
        PG8_WAIT_V(4); PG8_BAR;
        PG8_STAGE(PG8_SB(1, 0), cB + kstep, voffB); PG8_STAGE(PG8_SA(1, 0), cA + kstep, voffA); PG8_STAGE(PG8_SB(1, 1), cB + hstepB + kstep, voffB);
        PG8_WAIT_V(6); PG8_BAR;
    }
    for (;;) {
        const bool has_next = S.next(ui + 1, nxt);
        const char* nA = has_next ? (const char*)g.A + (size_t)nxt.pm * tstepA : cA; const char* nB = has_next ? (const char*)g.Bt + (size_t)nxt.pn * tstepB : cB;
        for (int t = 0; t < nt; t += 2) {
            const bool last = (t == nt - 2);
            const char* a1 = cA + (size_t)(t + 1) * kstep;
            const char* a2 = last ? nA : cA + (size_t)(t + 2) * kstep; const char* b2 = last ? nB : cB + (size_t)(t + 2) * kstep;
            const char* a3 = a2 + kstep; const char* b3 = b2 + kstep;
            if (last && has_next) S.a_ready(nxt);
            if constexpr (SP2) {
            PG8_LDB(B0, 0, 0); PG8_LDB(B1, 0, 1); PG8_SCHED; PG8_LDA(At, 0, 0); PG8_STAGE(PG8_SA(1, 1), a1 + hstepA, voffA);
            PG8_WAIT_V(8); PG8_WAIT_L(0); PG8_BAR; PG8_MMA(0, 0, At, B0); PG8_MMA(0, 1, At, B1); PG8_BAR; PG8_SCHED;
            PG8_LDA(At, 0, 1); PG8_STAGE(PG8_SB(0, 0), b2, voffB); PG8_STAGE(PG8_SB(0, 1), b2 + hstepB, voffB); PG8_STAGE(PG8_SA(0, 0), a2, voffA);
            PG8_WAIT_V(8); PG8_WAIT_L(0); PG8_BAR; PG8_MMA(1, 0, At, B0); PG8_MMA(1, 1, At, B1); PG8_BAR; PG8_SCHED;
            PG8_LDB(B0, 1, 0); PG8_LDB(B1, 1, 1); PG8_SCHED; PG8_LDA(At, 1, 0); PG8_STAGE(PG8_SA(0, 1), a2 + hstepA, voffA);
            PG8_WAIT_V(8); PG8_WAIT_L(0); PG8_BAR; PG8_MMA(0, 0, At, B0); PG8_MMA(0, 1, At, B1); PG8_BAR; PG8_SCHED;
            PG8_LDA(At, 1, 1); PG8_STAGE(PG8_SB(1, 0), b3, voffB); PG8_STAGE(PG8_SB(1, 1), b3 + hstepB, voffB); PG8_STAGE(PG8_SA(1, 0), a3, voffA);
            PG8_WAIT_V(8); PG8_WAIT_L(0); PG8_BAR; PG8_MMA(1, 0, At, B0); PG8_MMA(1, 1, At, B1); PG8_BAR; PG8_SCHED;
            } else {
            PG8_LDB(B0, 0, 0); PG8_SCHED; PG8_LDA(At, 0, 0); PG8_STAGE(PG8_SA(1, 1), a1 + hstepA, voffA);
            PG8_WAIT_L(8); PG8_BAR; PG8_WAIT_L(0); PG8_MMA(0, 0, At, B0); PG8_BAR; PG8_SCHED;
            PG8_LDB(B1, 0, 1); PG8_STAGE(PG8_SB(0, 0), b2, voffB);
            PG8_BAR; PG8_WAIT_L(0); PG8_MMA(0, 1, At, B1); PG8_BAR;
            PG8_LDA(At, 0, 1); PG8_STAGE(PG8_SA(0, 0), a2, voffA);
            PG8_BAR; PG8_WAIT_L(0); PG8_MMA(1, 0, At, B0); PG8_BAR; PG8_SCHED;
            PG8_STAGE(PG8_SB(0, 1), b2 + hstepB, voffB);
            PG8_WAIT_V(6); PG8_BAR; PG8_MMA(1, 1, At, B1); PG8_BAR;
            PG8_LDB(B0, 1, 0); PG8_SCHED; PG8_LDA(At, 1, 0); PG8_STAGE(PG8_SA(0, 1), a2 + hstepA, voffA);
            PG8_WAIT_L(8); PG8_BAR; PG8_WAIT_L(0); PG8_MMA(0, 0, At, B0); PG8_BAR; PG8_SCHED;
            PG8_LDB(B1, 1, 1); PG8_STAGE(PG8_SB(1, 0), b3, voffB);
            PG8_BAR; PG8_WAIT_L(0); PG8_MMA(0, 1, At, B1); PG8_BAR;
            PG8_LDA(At, 1, 1); PG8_STAGE(PG8_SA(1, 0), a3, voffA);
            PG8_BAR; PG8_WAIT_L(0); PG8_MMA(1, 0, At, B0); PG8_BAR; PG8_SCHED;
            PG8_STAGE(PG8_SB(1, 1), b3 + hstepB, voffB);
            PG8_WAIT_V(6); PG8_BAR; PG8_MMA(1, 1, At, B1); PG8_BAR;
            }
        }
        if constexpr (ALIGN_EPI) { if (wr == 0) PG8_BAR; }
        if constexpr (!Epi::AFTER_DRAIN) { E(acc, cur, wr, wc, fr, fq); S.done(cur); }
        if (!has_next) break;
#pragma unroll
        for (int a = 0; a < 2; ++a)
#pragma unroll
            for (int b = 0; b < 2; ++b)
#pragma unroll
                for (int m = 0; m < 4; ++m)
#pragma unroll
                    for (int n = 0; n < 2; ++n) acc[a][b][m][n] = (f32x4){0.f, 0.f, 0.f, 0.f};
        cur = nxt; cA = nA; cB = nB; ++ui;
        if constexpr (ALIGN_EPI) { if (wr == 1) PG8_BAR; }
    }
    PG8_WAIT_V(0);
    if constexpr (!ALIGN_EPI) { if (wr == 0) PG8_BAR; }
    PG8_BAR;
    if constexpr (Epi::AFTER_DRAIN) { E.fused(acc, cur, wr, wc, fr, fq, lds, wid, lane); S.done(cur); }
#undef PG8_SA
#undef PG8_SB
#undef PG8_STAGE
#undef PG8_LDA
#undef PG8_LDB
#undef PG8_MMA
#undef PG8_WAIT_V
#undef PG8_WAIT_L
#undef PG8_BAR
#undef PG8_SCHED
}
struct SubOrder {
  StaticOrder so; int pm0, pn0;
  __device__ void init(int nM, int nN, int pm0_, int pn0_, int wgm_ = WGM) { so.init(nM * BM, nN * BM, gridDim.x, blockIdx.x); so.wgm = wgm_; pm0 = pm0_; pn0 = pn0_; }
  __device__ bool next(int i, Unit& u) const { if (!so.next(i, u)) return false; u.pm += pm0; u.pn += pn0; return true; }
  __device__ __forceinline__ void a_ready(const Unit&) const {}
  __device__ __forceinline__ void done(const Unit&) const {}
};
struct ProjOrder {
  StaticOrder so; int G, c;
  __device__ void init() { G = gridDim.x; c = blockIdx.x; so.init(TL, NPROJP, G, c); so.wgm = WGM_PROJ; }
  __device__ bool next(int i, Unit& u) const {
    const long L = (long)i * G + c;
    if (L < 128 * 19) return so.next(i, u);
    const int idx = (int)L - 128 * 19;
    if (idx >= 96) return false;
    const int k = idx % 6;
    u.pm = 128 + idx / 6; u.pn = (k < 4) ? (2 + k) : (5 + k);
    return true;
  }
  __device__ __forceinline__ void a_ready(const Unit&) const {}
  __device__ __forceinline__ void done(const Unit&) const {}
};

struct ShiftOrder {
  int pm0, c0, n;
  __device__ bool next(int i, Unit& u) const {
    const int idx = (int)blockIdx.x - c0;
    if (i > 0 || idx < 0 || idx >= n) return false;
    u.pm = pm0 + (idx >> 2); u.pn = idx & 3;
    return true;
  }
  __device__ __forceinline__ void a_ready(const Unit&) const {}
  __device__ __forceinline__ void done(const Unit&) const {}
};
struct KvOrder {
  __device__ bool next(int i, Unit& u) const {
    const int c = blockIdx.x;
    int idx;
    if (gridDim.x != 256) { idx = i * (int)gridDim.x + c; if (idx >= 576) return false; }
    else if (c >= 128) { if (i >= 4) return false; idx = (c - 128) * 4 + i; }
    else if (c < 64) { if (i >= 1) return false; idx = 512 + c; }
    else return false;
    u.pm = idx >> 2; u.pn = idx & 3;
    return true;
  }
  __device__ __forceinline__ void a_ready(const Unit&) const {}
  __device__ __forceinline__ void done(const Unit&) const {}
};
struct EpiStoreF32 {
  static constexpr bool PERM = true, AFTER_DRAIN = false;
  float* Yp; int row0;
  __device__ __forceinline__ void operator()(const f32x4 (&acc)[2][2][4][2], const Unit& u, int wr, int wc, int fr, int fq) const {
    asm volatile("" : "+v"(fr), "+v"(fq));
#pragma unroll
    for (int ai = 0; ai < 2; ++ai)
#pragma unroll
      for (int m = 0; m < 4; ++m) {
        const size_t row = (size_t)u.pm * BM + ai * HALF + wr * 64 + m * 16 + fr - row0;
#pragma unroll
        for (int bj = 0; bj < 2; ++bj) {
          float* d = Yp + row * 1024 + u.pn * BM + bj * HALF + wc * 32 + 8 * fq;
          *(f32x4*)d = acc[ai][bj][m][0]; *(f32x4*)(d + 4) = acc[ai][bj][m][1];
        }
      }
  }
};

struct EpiSwiglu {
  static constexpr bool PERM = true, AFTER_DRAIN = false;
  bf16_t* U;
  __device__ __forceinline__ void operator()(const f32x4 (&acc)[2][2][4][2], const Unit& u, int wr, int wc, int fr, int fq) const {
    asm volatile("" : "+v"(fr), "+v"(fq));
#pragma unroll
    for (int ai = 0; ai < 2; ++ai)
#pragma unroll
      for (int m = 0; m < 4; ++m) {
        const size_t row = (size_t)u.pm * BM + ai * HALF + wr * 64 + m * 16 + fr;
        f32x4 v[2];
#pragma unroll
        for (int n = 0; n < 2; ++n) {
          const f32x4 a = acc[ai][0][m][n], b = acc[ai][1][m][n];
#pragma unroll
          for (int j = 0; j < 4; ++j) v[n][j] = a[j] * __builtin_amdgcn_rcpf(1.f + __builtin_amdgcn_exp2f(-LOG2E * a[j])) * b[j];
        }
        u32x4 w; w.x = pk_bf16(v[0][0], v[0][1]); w.y = pk_bf16(v[0][2], v[0][3]); w.z = pk_bf16(v[1][0], v[1][1]); w.w = pk_bf16(v[1][2], v[1][3]);
        *(u32x4*)(U + row * DFF + u.pn * 128 + wc * 32 + 8 * fq) = w;
      }
  }
};

struct EpiStoreSsq {
  static constexpr bool PERM = true, AFTER_DRAIN = false;
  bf16_t* Y; float* ssq;
  __device__ __forceinline__ void operator()(const f32x4 (&acc)[2][2][4][2], const Unit& u, int wr, int wc, int fr, int fq) const {
    asm volatile("" : "+v"(fr), "+v"(fq));
#pragma unroll
    for (int ai = 0; ai < 2; ++ai)
#pragma unroll
      for (int m = 0; m < 4; ++m) {
        const size_t row = (size_t)u.pm * BM + ai * HALF + wr * 64 + m * 16 + fr;
        float s = 0.f;
#pragma unroll
        for (int bj = 0; bj < 2; ++bj) {
          const f32x4 v0 = acc[ai][bj][m][0], v1 = acc[ai][bj][m][1];
          s += v0[0] * v0[0] + v0[1] * v0[1] + v0[2] * v0[2] + v0[3] * v0[3] + v1[0] * v1[0] + v1[1] * v1[1] + v1[2] * v1[2] + v1[3] * v1[3];
          u32x4 w; w.x = pk_bf16(v0[0], v0[1]); w.y = pk_bf16(v0[2], v0[3]); w.z = pk_bf16(v1[0], v1[1]); w.w = pk_bf16(v1[2], v1[3]);
          *(u32x4*)(Y + row * 1024 + u.pn * BM + bj * HALF + wc * 32 + 8 * fq) = w;
        }
        s += __shfl_xor(s, 16); s += __shfl_xor(s, 32);
        if (fq == 0) atomicAdd(ssq + row, s);
      }
  }
};

struct EpiProj {
  static constexpr bool PERM = true, AFTER_DRAIN = false;
  bf16_t* big; const float* b_gate; const float* ropecs; float* ssq_q; float* ssq_kv;
  __device__ __forceinline__ void operator()(const f32x4 (&acc)[2][2][4][2], const Unit& u, int wr, int wc, int fr, int fq) const {
    asm volatile("" : "+v"(fr), "+v"(fq));
    const int pn = u.pn;
    const bool latent = u.pm < 128;
    if (pn < 6) {
      bf16_t* dst = big + ((pn < 2) ? OFF_QA : (pn < 4) ? OFF_KA : OFF_VA);
      const float sc = (pn < 2) ? 0.125f * LOG2E : 1.f;
      const int c0 = (pn & 1) * 256;
#pragma unroll
      for (int ai = 0; ai < 2; ++ai)
#pragma unroll
        for (int m = 0; m < 4; ++m) {
          const size_t row = (size_t)u.pm * BM + ai * HALF + wr * 64 + m * 16 + fr;
#pragma unroll
          for (int bj = 0; bj < 2; ++bj) store_bf16x8(dst + row * 512 + c0 + bj * HALF + wc * 32 + 8 * fq, acc[ai][bj][m][0] * sc, acc[ai][bj][m][1] * sc);
          asm volatile("" ::: "memory");
        }
    } else if (pn < 10) {
      const bool isq = pn < 9;
      bf16_t* dst = big + (isq ? OFF_CQ : OFF_CKV);
      const int ld = isq ? 768 : 256, c0 = isq ? (pn - 6) * 256 : 0;
      float* ssq = isq ? ssq_q : ssq_kv;
#pragma unroll
      for (int ai = 0; ai < 2; ++ai)
#pragma unroll
        for (int m = 0; m < 4; ++m) {
          const size_t row = (size_t)u.pm * BM + ai * HALF + wr * 64 + m * 16 + fr;
          float s = 0.f;
#pragma unroll
          for (int bj = 0; bj < 2; ++bj) {
            const f32x4 v0 = acc[ai][bj][m][0], v1 = acc[ai][bj][m][1];
            s += v0[0] * v0[0] + v0[1] * v0[1] + v0[2] * v0[2] + v0[3] * v0[3] + v1[0] * v1[0] + v1[1] * v1[1] + v1[2] * v1[2] + v1[3] * v1[3];
            store_bf16x8(dst + row * ld + c0 + bj * HALF + wc * 32 + 8 * fq, v0, v1);
          }
          s += __shfl_xor(s, 16); s += __shfl_xor(s, 32);
          if (fq == 0) atomicAdd(ssq + row, s);
          asm volatile("" ::: "memory");
        }
    } else {
#pragma unroll
      for (int bj = 0; bj < 2; ++bj) {
        const int colg = pn * BM + bj * HALF + wc * 32;
        if (colg == 2560) {
#pragma unroll
          for (int ai = 0; ai < 2; ++ai)
#pragma unroll
            for (int m = 0; m < 4; ++m) {
              const int row = u.pm * BM + ai * HALF + wr * 64 + m * 16 + fr;
              f32x4 v0 = acc[ai][bj][m][0], v1 = acc[ai][bj][m][1];
              if (latent) {
                const int t = row & 2047;
                v0 = rope4p(v0, 0, fq, t >> 6, t & 63, ropecs);
                v1 = rope4p(v1, 1, fq, t >> 6, t & 63, ropecs);
              }
              store_bf16x8(big + OFF_KR + (size_t)row * 32 + 8 * fq, v0, v1);
              asm volatile("" ::: "memory");
            }
        } else if (colg < NPROJ && latent) {
          const int gc = colg - 2592 + 8 * fq;
          const f32x4 bg0 = *(const f32x4*)(b_gate + gc), bg1 = *(const f32x4*)(b_gate + gc + 4);
#pragma unroll
          for (int ai = 0; ai < 2; ++ai)
#pragma unroll
            for (int m = 0; m < 4; ++m) {
              const int row = u.pm * BM + ai * HALF + wr * 64 + m * 16 + fr;
              f32x4 v0 = acc[ai][bj][m][0] + bg0, v1 = acc[ai][bj][m][1] + bg1;
#pragma unroll
              for (int j = 0; j < 4; ++j) {
                v0[j] = __builtin_amdgcn_rcpf(1.f + __builtin_amdgcn_exp2f(-LOG2E * v0[j]));
                v1[j] = __builtin_amdgcn_rcpf(1.f + __builtin_amdgcn_exp2f(-LOG2E * v1[j]));
              }
              store_bf16x8(big + OFF_G + (size_t)row * 2048 + gc, v0, v1);
              asm volatile("" ::: "memory");
            }
        }
      }
    }
  }
};

struct EpiQup {
  static constexpr bool PERM = true, AFTER_DRAIN = false;
  bf16_t* QM; const float* ssq_q; const float* ropecs;
  __device__ __forceinline__ void operator()(const f32x4 (&acc)[2][2][4][2], const Unit& u, int wr, int wc, int fr, int fq) const {
    asm volatile("" : "+v"(fr), "+v"(fq));
#pragma unroll
    for (int ai = 0; ai < 2; ++ai)
#pragma unroll
      for (int m = 0; m < 4; ++m) {
        const int row = u.pm * BM + ai * HALF + wr * 64 + m * 16 + fr;
        const float rs = rsqrtf(ssq_q[row] * (1.f / 768.f) + RMS_EPS) * (0.10206207261596575f * LOG2E);
        const int t = row & 2047;
#pragma unroll
        for (int bj = 0; bj < 2; ++bj) {
          const int colg = u.pn * BM + bj * HALF + wc * 32;
          f32x4 v0 = acc[ai][bj][m][0] * rs, v1 = acc[ai][bj][m][1] * rs;
          if (colg % 96 == 64) {
            v0 = rope4p(v0, 0, fq, t >> 6, t & 63, ropecs);
            v1 = rope4p(v1, 1, fq, t >> 6, t & 63, ropecs);
          }
          store_bf16x8(QM + (size_t)row * 768 + colg + 8 * fq, v0, v1);
        }
      }
  }
};

struct EpiKVup {
  static constexpr bool PERM = true, AFTER_DRAIN = false;
  bf16_t* KV; const float* ssq_kv;
  __device__ __forceinline__ void operator()(const f32x4 (&acc)[2][2][4][2], const Unit& u, int wr, int wc, int fr, int fq) const {
    asm volatile("" : "+v"(fr), "+v"(fq));
#pragma unroll
    for (int ai = 0; ai < 2; ++ai)
#pragma unroll
      for (int m = 0; m < 4; ++m) {
        const int row = u.pm * BM + ai * HALF + wr * 64 + m * 16 + fr;
        const float rs = rsqrtf(ssq_kv[row] * (1.f / 256.f) + RMS_EPS);
#pragma unroll
        for (int bj = 0; bj < 2; ++bj) store_bf16x8(KV + (size_t)row * 1024 + u.pn * BM + bj * HALF + wc * 32 + 8 * fq, acc[ai][bj][m][0] * rs, acc[ai][bj][m][1] * rs);
      }
  }
};

template <bool ADD>
struct EpiGate {
  static constexpr bool PERM = true, AFTER_DRAIN = false;
  bf16_t* Y1; const bf16_t* G; int gcol0;
  __device__ __forceinline__ void operator()(const f32x4 (&acc)[2][2][4][2], const Unit& u, int wr, int wc, int fr, int fq) const {
    asm volatile("" : "+v"(fr), "+v"(fq));
#pragma unroll
    for (int ai = 0; ai < 2; ++ai)
#pragma unroll
      for (int m = 0; m < 4; ++m) {
        const size_t row = (size_t)u.pm * BM + ai * HALF + wr * 64 + m * 16 + fr;
#pragma unroll
        for (int bj = 0; bj < 2; ++bj) {
          const int col = u.pn * BM + bj * HALF + wc * 32 + 8 * fq;
          f32x4 g0, g1; load_bf16x8(G + row * 2048 + gcol0 + col, g0, g1);
          f32x4 v0 = acc[ai][bj][m][0] * g0, v1 = acc[ai][bj][m][1] * g1;
          if (ADD) { f32x4 y0, y1; load_bf16x8(Y1 + row * 1024 + col, y0, y1); v0 = v0 + y0; v1 = v1 + y1; }
          store_bf16x8(Y1 + row * 1024 + col, v0, v1);
        }
      }
  }
};
}

#define LAS __attribute__((address_space(3)))
#define XB_TMO      128
#define XB_XCNT(j)  (256  + 64 * (j))
#define XB_XSUB(j)  (1280 + 64 * (j))
#define XB_XGEN(j)  (2304 + 64 * (j))
#define XB_TOP      3328
#define XB_TOPGEN   3392
#define XCD_BAR_WORDS 3456
#define XB_SPIN_CAP (1u << 18)

__device__ __forceinline__ unsigned xb_ld(unsigned* p)              { return __hip_atomic_load(p, __ATOMIC_RELAXED, __HIP_MEMORY_SCOPE_AGENT); }
__device__ __forceinline__ unsigned xb_add(unsigned* p, unsigned v) { return __hip_atomic_fetch_add(p, v, __ATOMIC_RELAXED, __HIP_MEMORY_SCOPE_AGENT); }
__device__ __forceinline__ unsigned xb_xcc_id() { return (unsigned)__builtin_amdgcn_s_getreg((3 << 11) | 20) & 0xFu; }
#define XB_SPIN(cond, bar) do { unsigned _sp = 0; while (cond) { __builtin_amdgcn_s_sleep(1); \
    if ((++_sp & 255u) == 0u) { if (xb_ld(&(bar)[XB_TMO])) break; if (_sp > XB_SPIN_CAP) { atomicAdd(&(bar)[XB_TMO], 1u); break; } } } } while (0)

struct XcdBarrier {
    unsigned* bar; unsigned x;
    volatile LAS unsigned* st;
};

__device__ __forceinline__ XcdBarrier xcd_barrier_post(unsigned* bar, volatile LAS unsigned* st) {
    XcdBarrier b; b.bar = bar; b.x = xb_xcc_id(); b.st = st;
    if (threadIdx.x == 0) (void)xb_add(&bar[XB_XCNT(b.x)], 1u);
    return b;
}
__device__ __forceinline__ void xcd_barrier_complete(unsigned* bar, unsigned x, unsigned& nloc, unsigned& nx) {
    const unsigned G = gridDim.x * gridDim.y * gridDim.z;
    unsigned sum, cnt, mine, sp = 0u;
    for (;;) {
        sum = 0u; cnt = 0u; mine = 0u;
#pragma unroll
        for (unsigned j = 0; j < 16; ++j) { const unsigned c = xb_ld(&bar[XB_XCNT(j)]); sum += c; cnt += (c > 0u) ? 1u : 0u; mine = (j == x) ? c : mine; }
        if (sum == G) break;
        __builtin_amdgcn_s_sleep(1);
        if ((++sp & 255u) == 0u) { if (xb_ld(&bar[XB_TMO])) break; if (sp > XB_SPIN_CAP) { atomicAdd(&bar[XB_TMO], 1u); break; } }
    }
    nloc = mine > 0u ? mine : 1u; nx = cnt > 0u ? cnt : 1u;
}

__device__ __forceinline__ void xcd_barrier(const XcdBarrier& b) {
    asm volatile("s_waitcnt vmcnt(0)" ::: "memory");
    __syncthreads();
    if (threadIdx.x == 0) {
        unsigned* bar = b.bar;
        __builtin_amdgcn_s_waitcnt(0);
        unsigned nloc = b.st[0], nx = b.st[1];
        if (nloc == 0u) { xcd_barrier_complete(bar, b.x, nloc, nx); b.st[0] = nloc; b.st[1] = nx; }
        const unsigned old = xb_add(&bar[XB_XSUB(b.x)], 1u);
        const unsigned gen = old / nloc;
        if (old + 1u == (gen + 1u) * nloc) {
            __builtin_amdgcn_fence(__ATOMIC_RELEASE, "agent");
            asm volatile("s_waitcnt vmcnt(0)" ::: "memory");
            const unsigned og = xb_add(&bar[XB_TOP], 1u);
            const unsigned tg = og / nx;
            if (og + 1u == (tg + 1u) * nx) xb_add(&bar[XB_TOPGEN], 1u);
            else XB_SPIN(xb_ld(&bar[XB_TOPGEN]) == tg, bar);
            __builtin_amdgcn_fence(__ATOMIC_ACQUIRE, "agent");
            xb_add(&bar[XB_XGEN(b.x)], 1u);
            asm volatile("s_waitcnt vmcnt(0)" ::: "memory");
        } else {
            XB_SPIN(xb_ld(&bar[XB_XGEN(b.x)]) == gen, bar);
            __builtin_amdgcn_fence(__ATOMIC_ACQUIRE, "agent");
            asm volatile("s_waitcnt vmcnt(0)" ::: "memory");
        }
    }
    __syncthreads();
}

DI void convert_pair(const Params& p, int wsel, int pair, float* ldsf_all) {
  const float* src1 = nullptr; const float* src2 = nullptr; const float* kscale = nullptr; bf16_t* dst = nullptr;
  int K = 0, ld = 0, nvalid = 0, kind = 0;
  switch (wsel) {
    case 0: src1 = p.f1w1; src2 = p.f1w3; dst = p.W13a; K = 1024; ld = DFF; nvalid = 5632; kind = 1; break;
    case 1: src1 = p.f1w2; dst = p.W2a; K = DFF; ld = 1024; nvalid = 1024; break;
    case 2: src1 = p.w_in; dst = p.Win; K = 1024; ld = NPROJ; nvalid = NPROJ; break;
    case 3: src1 = p.w_uq; dst = p.Wuq; K = 768; ld = 768; nvalid = 768; kscale = p.g_q; break;
    case 4: src1 = p.w_ukv; dst = p.Wukv; K = 256; ld = 1024; nvalid = 1024; kscale = p.g_kv; break;
    case 5: src1 = p.w_o_na; dst = p.Wona; K = 512; ld = 1024; nvalid = 1024; break;
    case 6: src1 = p.w_o_mla; dst = p.Womla; K = 512; ld = 1024; nvalid = 1024; break;
    case 7: src1 = p.w_out; dst = p.Wout; K = 1024; ld = 1024; nvalid = 1024; break;
    case 8: src1 = p.f2w1; src2 = p.f2w3; dst = p.W13b; K = 1024; ld = DFF; nvalid = 5632; kind = 1; break;
    default: src1 = p.f2w2; dst = p.W2b; K = DFF; ld = 1024; nvalid = 1024; break;
  }
  const int t512 = ltid(); const int half = t512 >> 8, tid = t512 & 255, lane = tid & 63, w = tid >> 6;
  float* ldsf = ldsf_all + half * (64 * 65);
  const int tile = pair * 2 + half;
  const int nkt = K >> 6;
  const int kt = tile % nkt, nt = tile / nkt;
  {
    const int n = nt * 64 + lane;
    const float* s = src1; int col = n; const bool valid = n < nvalid;
    if (kind == 1) {
      const int pn = n >> 8, bj = (n >> 7) & 1, cc = n & 127;
      col = 128 * pn + cc;
      s = bj ? src2 : src1;
    }
    float tv[16];
#pragma unroll
    for (int kk = 0; kk < 16; ++kk) {
      const int k = kt * 64 + w * 16 + kk;
      tv[kk] = valid ? s[(size_t)k * ld + col] : 0.f;
    }
#pragma unroll
    for (int kk = 0; kk < 16; ++kk) {
      const int kl = w * 16 + kk, k = kt * 64 + kl;
      float v = tv[kk];
      if (kscale) v *= kscale[k];
      ldsf[kl * 65 + lane] = v;
    }
  }
  __syncthreads();
  {
    const int r = tid >> 2, kq = (tid & 3) * 16;
    u32x4 o0, o1;
    float v[16];
#pragma unroll
    for (int i = 0; i < 16; ++i) v[i] = ldsf[(kq + i) * 65 + r];
    o0.x = pk_bf16(v[0], v[1]); o0.y = pk_bf16(v[2], v[3]); o0.z = pk_bf16(v[4], v[5]); o0.w = pk_bf16(v[6], v[7]);
    o1.x = pk_bf16(v[8], v[9]); o1.y = pk_bf16(v[10], v[11]); o1.z = pk_bf16(v[12], v[13]); o1.w = pk_bf16(v[14], v[15]);
    bf16_t* d = dst + (size_t)(nt * 64 + r) * K + kt * 64 + kq;
    *(u32x4*)d = o0; *(u32x4*)(d + 8) = o1;
  }
  __syncthreads();
}

DI void adaln_unit(const Params& p, int u, float* ldsf) {
  const int tid = ltid(), lane = tid & 63, kg = tid >> 6;
  {
    float cv[34];
#pragma unroll
    for (int i = 0; i < 34; ++i) {
      const int idx = tid + NT * i, r = idx >> 10, k = idx & 1023;
      cv[i] = (r < 16) ? p.c[r * 1024 + k] : p.c_ctx[k];
    }
#pragma unroll
    for (int i = 0; i < 34; ++i) ldsf[tid + NT * i] = cv[i] * __builtin_amdgcn_rcpf(1.f + __builtin_amdgcn_exp2f(-LOG2E * cv[i]));
  }
  __syncthreads();
  const int col = u * 64 + lane;
  float acc[17];
#pragma unroll
  for (int r = 0; r < 17; ++r) acc[r] = 0.f;
  const float* wp = p.w_ada + (size_t)(kg * 128) * 9216 + col;
  const float* sp = ldsf + kg * 128;
#pragma unroll 1
  for (int k0 = 0; k0 < 128; k0 += 16) {
    float wv[16];
#pragma unroll
    for (int kk = 0; kk < 16; ++kk) wv[kk] = wp[(size_t)(k0 + kk) * 9216];
#pragma unroll
    for (int kk = 0; kk < 16; ++kk)
#pragma unroll
      for (int r = 0; r < 17; ++r) acc[r] += sp[r * 1024 + k0 + kk] * wv[kk];
  }
  __syncthreads();
#pragma unroll
  for (int r = 0; r < 17; ++r) ldsf[(kg * 17 + r) * 64 + lane] = acc[r];
  __syncthreads();
  for (int idx = tid; idx < 17 * 64; idx += NT) {
    const int r = idx >> 6, cl = idx & 63;
    float s = 0.f;
#pragma unroll
    for (int g = 0; g < 8; ++g) s += ldsf[(g * 17 + r) * 64 + cl];
    p.mod[r * 9216 + u * 64 + cl] = s + p.b_ada[u * 64 + cl];
  }
  __syncthreads();
}

DI void phase0(const Params& p, float* ldsf) {
  const int G = gridDim.x, bid = blockIdx.x, tid = ltid();
  for (int i = bid * NT + tid; i < 5 * TA; i += G * NT) p.ssq[i] = 0.f;
  if (bid == G - 1) {
    for (int idx = tid; idx < 512; idx += NT) {
      const int pos = idx >> 3, i = idx & 7;
      float freq;
      switch (i) { case 0: freq = 1.0f; break; case 1: freq = 0.31622776601683794f; break; case 2: freq = 0.1f; break; case 3: freq = 0.031622776601683794f; break;
                   case 4: freq = 0.01f; break; case 5: freq = 0.0031622776601683794f; break; case 6: freq = 0.001f; break; default: freq = 0.00031622776601683794f; break; }
      const float angf = (float)pos * freq;
      const double a = (double)angf;
      const double n = __builtin_rint(a * 0.6366197723675814);
      const double rr = (a - n * 1.5707963267948966) - n * 6.123233995736766e-17;
      const int qd = ((int)n) & 3;
      const double r2 = rr * rr;
      const double sr = rr * (1.0 + r2 * (-1.0 / 6 + r2 * (1.0 / 120 + r2 * (-1.0 / 5040 + r2 * (1.0 / 362880 + r2 * (-1.0 / 39916800 + r2 * (1.0 / 6227020800.0)))))));
      const double cr = 1.0 + r2 * (-0.5 + r2 * (1.0 / 24 + r2 * (-1.0 / 720 + r2 * (1.0 / 40320 + r2 * (-1.0 / 3628800 + r2 * (1.0 / 479001600.0 + r2 * (-1.0 / 87178291200.0)))))));
      double sn, cs;
      if (qd == 0) { sn = sr; cs = cr; } else if (qd == 1) { sn = cr; cs = -sr; } else if (qd == 2) { sn = -sr; cs = -cr; } else { sn = -cr; cs = sr; }
      p.ropecs[idx] = (float)cs;
      p.ropecs[512 + idx] = (float)sn;
    }
  }
  constexpr int NT0 = 16 * 88 / 2;
  constexpr int NADA = 144;
  constexpr int TOTAL = NADA + NT0;
  if (G == 256) {
    if (bid < NADA) { adaln_unit(p, bid, ldsf); convert_pair(p, 0, bid, ldsf); }
    else { for (int i = 0; i < 5; ++i) convert_pair(p, 0, NADA + (bid - NADA) * 5 + i, ldsf); }
  } else {
    for (int u = bid; u < TOTAL; u += G) {
      if (u < NADA) { adaln_unit(p, u, ldsf); continue; }
      convert_pair(p, 0, u - NADA, ldsf);
    }
  }
}

DI void convert_w2a(const Params& p, float* ldsf, int first) {
  const int n = gridDim.x - first, me = blockIdx.x - first;
  if (me < 0) return;
  constexpr int NT1 = 44 * 16 / 2, NT2 = 16 * 76 / 2, NT3 = 12 * 12 / 2, NT4 = 4 * 16 / 2, NT5 = 8 * 16 / 2, NT6 = 8 * 16 / 2, NT7 = 16 * 16 / 2;
  constexpr int TOTAL = NT1 + NT2 + NT3 + NT4 + NT5 + NT6 + NT7;
  for (int u = me; u < TOTAL; u += n) {
    int t = u;
    if (t < NT1) { convert_pair(p, 1, t, ldsf); continue; } t -= NT1;
    if (t < NT2) { convert_pair(p, 2, t, ldsf); continue; } t -= NT2;
    if (t < NT3) { convert_pair(p, 3, t, ldsf); continue; } t -= NT3;
    if (t < NT4) { convert_pair(p, 4, t, ldsf); continue; } t -= NT4;
    if (t < NT5) { convert_pair(p, 5, t, ldsf); continue; } t -= NT5;
    if (t < NT6) { convert_pair(p, 6, t, ldsf); continue; } t -= NT6;
    convert_pair(p, 7, t, ldsf);
  }
}
DI void convert_rest(const Params& p, float* ldsf, int first) {
  const int n = gridDim.x - first, me = blockIdx.x - first;
  if (me < 0) return;
  constexpr int NT0 = 16 * 88 / 2, NT1 = 44 * 16 / 2;
  for (int u = me; u < NT0 + NT1; u += n) {
    if (u < NT0) convert_pair(p, 8, u, ldsf);
    else convert_pair(p, 9, u - NT0, ldsf);
  }
}

template <int PASS>
DI void row_pass(const Params& p) {
  const int t512 = ltid(); const int lane = t512 & 63, wid = t512 >> 6;
  const int nrows = (PASS <= 2) ? TA : TL;
  const int gwave = blockIdx.x * NW + wid, nwaves = gridDim.x * NW;
  const int per = (nrows + nwaves - 1) / nwaves;
  const int rbeg = gwave * per, rend = min(rbeg + per, nrows);
  const float* ng = p.norm_g;
  const bf16_t* Y = p.big + ((PASS == 3) ? OFF_Y2 : OFF_Y);
  const float* ssq = p.ssq + ((PASS == 2) ? 0 : (PASS == 3) ? 3 * TA : 4 * TA);
  f32x4 cres[4], cmul[4], cadd[4];
  f32x4 xn[4]; u32x2 xbn[4]; u32x2 yn[4]; float sn = 0.f;
  int curb = -1;
  auto load_vecs = [&](int b) {
    curb = b;
      const float* mod = p.mod + (size_t)b * 9216;
#pragma unroll
      for (int i = 0; i < 4; ++i) {
        const int col = (i * 64 + lane) * 4;
        if (PASS >= 2) {
          const float* gpost = ng + ((PASS == 2) ? 1 : (PASS == 3) ? 3 : 5) * 1024;
          const float* gate = mod + ((PASS == 2) ? 2 : (PASS == 3) ? 5 : 8) * 1024;
          const float wgt = (PASS == 3) ? 1.0f : 0.5f;
          cres[i] = wgt * (*(const f32x4*)(gate + col)) * (*(const f32x4*)(gpost + col));
        }
        if (PASS <= 3) {
          const float* gpre = ng + ((PASS == 1) ? 0 : (PASS == 2) ? 2 : 4) * 1024;
          const float* shift = mod + ((PASS == 1) ? 0 : (PASS == 2) ? 3 : 6) * 1024;
          const float* scale = mod + ((PASS == 1) ? 1 : (PASS == 2) ? 4 : 7) * 1024;
          cmul[i] = (*(const f32x4*)(gpre + col)) * (1.f + *(const f32x4*)(scale + col));
          cadd[i] = *(const f32x4*)(shift + col);
        }
      }
  };
  const int rend_main = (PASS == 2) ? min(rend, TL) : rend;
  for (int row = rbeg; row < rend_main; ++row) {
    const int b = (row < TL) ? (row >> 11) : 16;
    if (b != curb) load_vecs(b);
    auto xload = [&](int r, f32x4 (&xf)[4], u32x2 (&xb)[4]) {
      if (PASS <= 2) {
        const float* s = (r < TL) ? p.x + (size_t)r * 1024 : p.ctx + (size_t)(r - TL) * 1024;
#pragma unroll
        for (int i = 0; i < 4; ++i) xf[i] = *(const f32x4*)(s + (i * 64 + lane) * 4);
      } else {
        const bf16_t* s = (const bf16_t*)(p.out + (size_t)r * 1024);
#pragma unroll
        for (int i = 0; i < 4; ++i) xb[i] = *(const u32x2*)(s + (i * 64 + lane) * 4);
      }
    };
    f32x4 xv[4]; u32x2 xbv[4]; u32x2 yw[4]; float sq = 0.f;
    if (row == rbeg) {
      xload(row, xv, xbv);
      if (PASS >= 2) {
        sq = ssq[row];
#pragma unroll
        for (int i = 0; i < 4; ++i) yw[i] = *(const u32x2*)(Y + (size_t)row * 1024 + (i * 64 + lane) * 4);
      }
    } else {
#pragma unroll
      for (int i = 0; i < 4; ++i) { xv[i] = xn[i]; xbv[i] = xbn[i]; yw[i] = yn[i]; }
      sq = sn;
    }
    if (row + 1 < rend_main) {
      const int nr = row + 1;
      xload(nr, xn, xbn);
      if (PASS >= 2) {
        sn = ssq[nr];
#pragma unroll
        for (int i = 0; i < 4; ++i) yn[i] = *(const u32x2*)(Y + (size_t)nr * 1024 + (i * 64 + lane) * 4);
      }
    }
    if (PASS >= 3) {
#pragma unroll
      for (int i = 0; i < 4; ++i) {
        const u32x2 w = xbv[i];
        xv[i] = (f32x4){__uint_as_float(w.x << 16), __uint_as_float(w.x & 0xffff0000u), __uint_as_float(w.y << 16), __uint_as_float(w.y & 0xffff0000u)};
      }
    }
    if (PASS >= 2) {
      const float rs = rsqrtf(sq * (1.f / 1024.f) + RMS_EPS);
#pragma unroll
      for (int i = 0; i < 4; ++i) {
        const int col = (i * 64 + lane) * 4;
        const u32x2 w = yw[i];
        const f32x4 yv = {__uint_as_float(w.x << 16), __uint_as_float(w.x & 0xffff0000u), __uint_as_float(w.y << 16), __uint_as_float(w.y & 0xffff0000u)};
        xv[i] = xv[i] + (yv * rs) * cres[i];
        if (PASS == 4) *(f32x4*)(p.out + (size_t)row * 1024 + col) = xv[i];
        else if (row < TL) store_bf16x4((bf16_t*)(p.out + (size_t)row * 1024) + col, xv[i]);
      }
    }
    if (PASS <= 3) {
      float s = 0.f;
#pragma unroll
      for (int i = 0; i < 4; ++i) s += xv[i][0] * xv[i][0] + xv[i][1] * xv[i][1] + xv[i][2] * xv[i][2] + xv[i][3] * xv[i][3];
      s = wave_sum(s);
      const float rs = rsqrtf(s * (1.f / 1024.f) + RMS_EPS);
#pragma unroll
      for (int i = 0; i < 4; ++i) {
        const int col = (i * 64 + lane) * 4;
        store_bf16x4(p.H + (size_t)row * 1024 + col, (xv[i] * rs) * cmul[i] + cadd[i]);
      }
    }
  }
  if (PASS == 2) {
    for (int row = max(rbeg, TL); row < rend; ++row) {
      if (curb != 16) load_vecs(16);
      const float* xs = p.ctx + (size_t)(row - TL) * 1024;
      const float* y0 = p.xc + (size_t)(row - TL) * 1024;
      const float* y1 = p.yc1 + (size_t)(row - TL) * 1024;
      f32x4 xv[4], yv[4];
#pragma unroll
      for (int i = 0; i < 4; ++i) {
        const int col = (i * 64 + lane) * 4;
        xv[i] = *(const f32x4*)(xs + col);
        yv[i] = *(const f32x4*)(y0 + col) + *(const f32x4*)(y1 + col);
      }
      float sy = 0.f;
#pragma unroll
      for (int i = 0; i < 4; ++i) sy += yv[i][0] * yv[i][0] + yv[i][1] * yv[i][1] + yv[i][2] * yv[i][2] + yv[i][3] * yv[i][3];
      sy = wave_sum(sy);
      const float rsy = rsqrtf(sy * (1.f / 1024.f) + RMS_EPS);
      float s = 0.f;
#pragma unroll
      for (int i = 0; i < 4; ++i) {
        xv[i] = xv[i] + (yv[i] * rsy) * cres[i];
        s += xv[i][0] * xv[i][0] + xv[i][1] * xv[i][1] + xv[i][2] * xv[i][2] + xv[i][3] * xv[i][3];
      }
      s = wave_sum(s);
      const float rs = rsqrtf(s * (1.f / 1024.f) + RMS_EPS);
#pragma unroll
      for (int i = 0; i < 4; ++i) {
        const int col = (i * 64 + lane) * 4;
        store_bf16x4(p.H + (size_t)row * 1024 + col, (xv[i] * rs) * cmul[i] + cadd[i]);
      }
    }
  }
}

DI void mla_unit(const Params& p, int unit, bf16_t* lds) {
  const int tid = ltid(), lane = tid & 63, wid = tid >> 6, fr = lane & 15, fq = lane >> 4;
  const int qb = unit & 7, h = (unit >> 3) & 7, b = unit >> 6;
  const bf16_t* QM = p.big + OFF_QM;
  const bf16_t* KV = p.H;
  const bf16_t* KR = p.big + OFF_KR;
  bf16_t* OM = p.big + OFF_OM;
  bf16_t* sK = lds;
  bf16_t* sV = lds + 2 * 64 * LDK;
  const int q0 = b * 2048 + qb * 256 + wid * 32;
  bf16x8 qf[2][3];
#pragma unroll
  for (int qt = 0; qt < 2; ++qt)
#pragma unroll
    for (int ks = 0; ks < 3; ++ks) qf[qt][ks] = *(const bf16x8*)(QM + (size_t)(q0 + qt * 16 + fr) * 768 + h * 96 + ks * 32 + fq * 8);

  const int kr0 = tid / 12, kc0 = tid - kr0 * 12;
  const int kr1 = (tid + 512) / 12, kc1 = (tid + 512) - kr1 * 12;
  const bool k2 = tid < 256;
  const int vrow = tid >> 3, vch = tid & 7;
  u32x4 rk0, rk1, rv;
  auto load_tile = [&](int kt) {
    const int kbase = kt * 64;
    const int rowbase = (kbase < 2048) ? (b * 2048 + kbase) : (TL + b * 256 + (kbase - 2048));
    {
      const size_t r = rowbase + kr0;
      rk0 = *(const u32x4*)((kc0 < 8) ? (KV + r * 1024 + h * 128 + kc0 * 8) : (KR + r * 32 + (kc0 - 8) * 8));
    }
    if (k2) {
      const size_t r = rowbase + kr1;
      rk1 = *(const u32x4*)((kc1 < 8) ? (KV + r * 1024 + h * 128 + kc1 * 8) : (KR + r * 32 + (kc1 - 8) * 8));
    }
    rv = *(const u32x4*)(KV + (size_t)(rowbase + vrow) * 1024 + h * 128 + 64 + vch * 8);
  };
  auto store_tile = [&](int buf) {
    *(u32x4*)(sK + buf * 64 * LDK + kr0 * LDK + kc0 * 8) = rk0;
    if (k2) *(u32x4*)(sK + buf * 64 * LDK + kr1 * LDK + kc1 * 8) = rk1;
    *(u32x4*)(sV + buf * 64 * LDV + vrow * LDV + vch * 8) = rv;
  };

  f32x4 o[4][2], lacc[2];
  float mref[2];
#pragma unroll
  for (int qt = 0; qt < 2; ++qt) {
    mref[qt] = 0.f; lacc[qt] = (f32x4){0.f, 0.f, 0.f, 0.f};
#pragma unroll
    for (int dt = 0; dt < 4; ++dt) o[dt][qt] = (f32x4){0.f, 0.f, 0.f, 0.f};
  }
  const bf16x8 ones = {(short)0x3F80, (short)0x3F80, (short)0x3F80, (short)0x3F80, (short)0x3F80, (short)0x3F80, (short)0x3F80, (short)0x3F80};
  load_tile(0);
  store_tile(0);
  __syncthreads();
  constexpr int NKT = 36;
  for (int kt = 0; kt < NKT; ++kt) {
    const int cur = kt & 1;
    const bool more = kt + 1 < NKT;
    if (more) load_tile(kt + 1);
    const bf16_t* cK = sK + cur * 64 * LDK;
    const bf16_t* cV = sV + cur * 64 * LDV;
    f32x4 s[4][2], sinit[2];
#pragma unroll
    for (int qt = 0; qt < 2; ++qt) { const float ni = -mref[qt]; sinit[qt] = (f32x4){ni, ni, ni, ni}; }
    bf16x8 kf[3][4];
#pragma unroll
    for (int ks = 0; ks < 3; ++ks)
#pragma unroll
      for (int t4 = 0; t4 < 4; ++t4) kf[ks][t4] = *(const bf16x8*)(cK + (t4 * 16 + fr) * LDK + ks * 32 + fq * 8);
#pragma unroll
    for (int ks = 0; ks < 3; ++ks)
#pragma unroll
      for (int t4 = 0; t4 < 4; ++t4)
#pragma unroll
        for (int qt = 0; qt < 2; ++qt) s[t4][qt] = mfma16(kf[ks][t4], qf[qt][ks], ks == 0 ? sinit[qt] : s[t4][qt]);
    s16x4 vlo[2][4], vhi[2][4];
#pragma unroll
    for (int s2 = 0; s2 < 2; ++s2)
#pragma unroll
      for (int dt = 0; dt < 4; ++dt) {
        const bf16_t* vp = cV + (s2 * 32 + 4 * fq + (fr >> 2)) * LDV + dt * 16 + 4 * (fr & 3);
        vlo[s2][dt] = tr_read(vp); vhi[s2][dt] = tr_read(vp + 16 * LDV);
      }
    __builtin_amdgcn_sched_barrier(0);
    float mx[2];
#pragma unroll
    for (int qt = 0; qt < 2; ++qt) {
      float v = fmaxf(fmaxf(s[0][qt][0], s[0][qt][1]), fmaxf(s[0][qt][2], s[0][qt][3]));
#pragma unroll
      for (int t4 = 1; t4 < 4; ++t4) v = fmaxf(v, fmaxf(fmaxf(s[t4][qt][0], s[t4][qt][1]), fmaxf(s[t4][qt][2], s[t4][qt][3])));
      v = fmaxf(v, __shfl_xor(v, 16)); v = fmaxf(v, __shfl_xor(v, 32));
      mx[qt] = v;
    }
    if (__any((kt == 0) || (mx[0] > 8.f) || (mx[1] > 8.f))) {
#pragma unroll
      for (int qt = 0; qt < 2; ++qt) {
        const float delta = (kt == 0) ? mx[qt] : fmaxf(mx[qt], 0.f);
        mref[qt] += delta;
        const float sc = __builtin_amdgcn_exp2f(-delta);
#pragma unroll
        for (int t4 = 0; t4 < 4; ++t4) s[t4][qt] = s[t4][qt] - delta;
#pragma unroll
        for (int dt = 0; dt < 4; ++dt) o[dt][qt] = o[dt][qt] * sc;
        lacc[qt] = lacc[qt] * sc;
      }
    }
    bf16x8 pf[2][2];
#pragma unroll
    for (int qt = 0; qt < 2; ++qt) {
#pragma unroll
      for (int t4 = 0; t4 < 4; ++t4)
#pragma unroll
        for (int j = 0; j < 4; ++j) s[t4][qt][j] = __builtin_amdgcn_exp2f(s[t4][qt][j]);
#pragma unroll
      for (int s2 = 0; s2 < 2; ++s2) {
        u32x4 w;
        w.x = pk_bf16(s[2 * s2][qt][0], s[2 * s2][qt][1]); w.y = pk_bf16(s[2 * s2][qt][2], s[2 * s2][qt][3]);
        w.z = pk_bf16(s[2 * s2 + 1][qt][0], s[2 * s2 + 1][qt][1]); w.w = pk_bf16(s[2 * s2 + 1][qt][2], s[2 * s2 + 1][qt][3]);
        pf[s2][qt] = __builtin_bit_cast(bf16x8, w);
      }
    }
#pragma unroll
    for (int s2 = 0; s2 < 2; ++s2) {
#pragma unroll
      for (int dt = 0; dt < 4; ++dt) {
        const bf16x8 vf = cat8(vlo[s2][dt], vhi[s2][dt]);
#pragma unroll
        for (int qt = 0; qt < 2; ++qt) o[dt][qt] = mfma16(vf, pf[s2][qt], o[dt][qt]);
      }
#pragma unroll
      for (int qt = 0; qt < 2; ++qt) lacc[qt] = mfma16(ones, pf[s2][qt], lacc[qt]);
    }
    if (more) store_tile(cur ^ 1);
    __syncthreads();
  }
#pragma unroll
  for (int qt = 0; qt < 2; ++qt) {
    const float inv = 1.f / lacc[qt][0];
#pragma unroll
    for (int dt = 0; dt < 4; ++dt) store_bf16x4(OM + (size_t)(q0 + qt * 16 + fr) * 512 + h * 64 + dt * 16 + 4 * fq, o[dt][qt] * inv);
  }
}

DI void na_unit(const Params& p, int unit, bf16_t* lds, float* srpb) {
  const int tid = ltid(), lane = tid & 63, wid = tid >> 6, j = wid & 3, fr = lane & 15, fq = lane >> 4;
  const int rp = unit & 15, h = (unit >> 4) & 7, b = unit >> 7;
  const int r = 2 * rp + (wid >> 2);
  const bf16_t* QA = p.big + OFF_QA;
  const bf16_t* KA = p.big + OFF_KA;
  const bf16_t* VA = p.big + OFF_VA;
  bf16_t* sVl = lds;
  bf16_t* sVc = lds + 576 * LDT;
  bf16_t* sKl = sVc;
  const int rs0 = min(max(2 * rp - 4, 0), 24);
  const int rs = min(max(r - 4, 0), 24);
  const int ks = min(max(16 * j - 8, 0), 32);
  bf16_t* sKc = lds + (256 + 576) * LDT;
#pragma unroll
  for (int i = 0; i < 4; ++i) {
    const int idx = tid + NT * i, row = idx >> 3, ch = idx & 7;
    *(u32x4*)(sVc + row * LDT + ch * 8) = *(const u32x4*)(VA + (size_t)(TL + b * 256 + row) * 512 + h * 64 + ch * 8);
    *(u32x4*)(sKc + row * LDT + ch * 8) = *(const u32x4*)(KA + (size_t)(TL + b * 256 + row) * 512 + h * 64 + ch * 8);
  }
  {
    u32x4 tv[9];
#pragma unroll
    for (int i = 0; i < 9; ++i) {
      const int idx = tid + NT * i, row = idx >> 3, ch = idx & 7;
      const size_t tok = (size_t)b * 2048 + (rs0 + (row >> 6)) * 64 + (row & 63);
      tv[i] = *(const u32x4*)(VA + tok * 512 + h * 64 + ch * 8);
    }
#pragma unroll
    for (int i = 0; i < 9; ++i) {
      const int idx = tid + NT * i, row = idx >> 3, ch = idx & 7;
      *(u32x4*)(sVl + row * LDT + ch * 8) = tv[i];
    }
  }
  u32x4 tk[9];
#pragma unroll
  for (int i = 0; i < 9; ++i) {
    const int idx = tid + NT * i, row = idx >> 3, ch = idx & 7;
    const size_t tok = (size_t)b * 2048 + (rs0 + (row >> 6)) * 64 + (row & 63);
    tk[i] = *(const u32x4*)(KA + tok * 512 + h * 64 + ch * 8);
  }
  if (tid < 465) srpb[tid] = p.rpb[h * 465 + tid] * LOG2E;
  const size_t qrow = (size_t)b * 2048 + r * 64 + 16 * j + fr;
  bf16x8 qf[2];
  qf[0] = *(const bf16x8*)(QA + qrow * 512 + h * 64 + fq * 8);
  qf[1] = *(const bf16x8*)(QA + qrow * 512 + h * 64 + 32 + fq * 8);
  f32x4 o[4], lacc = {0.f, 0.f, 0.f, 0.f};
#pragma unroll
  for (int dt = 0; dt < 4; ++dt) o[dt] = (f32x4){0.f, 0.f, 0.f, 0.f};
  float mref = 0.f;
  const int qc = 16 * j + fr;
  const int wst = min(max(qc - 8, 0), 48);
  const bf16x8 ones = {(short)0x3F80, (short)0x3F80, (short)0x3F80, (short)0x3F80, (short)0x3F80, (short)0x3F80, (short)0x3F80, (short)0x3F80};
  bf16x8 kf[4][2];
  auto load_k = [&](int ci) {
    if (ci < 4) {
#pragma unroll
      for (int t = 0; t < 4; ++t) {
        const bf16_t* kp = sKc + (ci * 64 + t * 16 + fr) * LDT + fq * 8;
        kf[t][0] = *(const bf16x8*)kp; kf[t][1] = *(const bf16x8*)(kp + 32);
      }
    } else {
      const int rbase = (rs - rs0 + 2 * (ci - 4)) * 64 + ks;
#pragma unroll
      for (int t = 0; t < 4; ++t) {
        const int rl = rbase + (t >> 1) * 64 + (t & 1) * 16 + fr;
        const bf16_t* kp = sKl + rl * 64;
        kf[t][0] = *(const bf16x8*)(kp + ((fq ^ (rl & 7)) * 8));
        kf[t][1] = *(const bf16x8*)(kp + (((4 + fq) ^ (rl & 7)) * 8));
      }
    }
  };
  int co8[2][4]; bool ok8[2][4];
#pragma unroll
  for (int e = 0; e < 2; ++e)
#pragma unroll
    for (int jj = 0; jj < 4; ++jj) {
      const int kc = ks + e * 16 + 4 * fq + jj;
      ok8[e][jj] = (kc >= wst) && (kc < wst + 16);
      co8[e][jj] = min(max(kc - qc, -15), 15) + 15;
    }
  __syncthreads();
  load_k(0);
#pragma unroll 1
  for (int ci = 0; ci < 8; ++ci) {
    const int half = ci >> 2, c = ci & 3;
    if (ci == 4) {
      __syncthreads();
#pragma unroll
      for (int i = 0; i < 9; ++i) {
        const int idx = tid + NT * i, row = idx >> 3, ch = idx & 7;
        *(u32x4*)(sKl + row * 64 + ((ch ^ (row & 7)) * 8)) = tk[i];
      }
      __syncthreads();
      load_k(4);
    }
    f32x4 s[4];
    const f32x4 sinit = {-mref, -mref, -mref, -mref};
#pragma unroll
    for (int t = 0; t < 4; ++t) {
      f32x4 a = mfma16(kf[t][0], qf[0], sinit);
      a = mfma16(kf[t][1], qf[1], a);
      s[t] = a;
    }
    if (ci < 7 && ci != 3) load_k(ci + 1);
    if (half == 1) {
      float bias[4][4];
#pragma unroll
      for (int t = 0; t < 4; ++t) {
        const int ro = (rs + 2 * c + (t >> 1) - r + 7) * 31;
#pragma unroll
        for (int jj = 0; jj < 4; ++jj) bias[t][jj] = srpb[ro + co8[t & 1][jj]];
      }
#pragma unroll
      for (int t = 0; t < 4; ++t)
#pragma unroll
        for (int jj = 0; jj < 4; ++jj) s[t][jj] = ok8[t & 1][jj] ? (s[t][jj] + bias[t][jj]) : -1e30f;
    }
    float mx = fmaxf(fmaxf(s[0][0], s[0][1]), fmaxf(s[0][2], s[0][3]));
#pragma unroll
    for (int t = 1; t < 4; ++t) mx = fmaxf(mx, fmaxf(fmaxf(s[t][0], s[t][1]), fmaxf(s[t][2], s[t][3])));
    mx = fmaxf(mx, __shfl_xor(mx, 16)); mx = fmaxf(mx, __shfl_xor(mx, 32));
    if (__any((ci == 0) || (mx > 8.f))) {
      const float delta = (ci == 0) ? mx : fmaxf(mx, 0.f);
      mref += delta;
      const float sc = __builtin_amdgcn_exp2f(-delta);
#pragma unroll
      for (int t = 0; t < 4; ++t) s[t] = s[t] - delta;
#pragma unroll
      for (int dt = 0; dt < 4; ++dt) o[dt] = o[dt] * sc;
      lacc = lacc * sc;
    }
#pragma unroll
    for (int s2 = 0; s2 < 2; ++s2) {
      f32x4 e0, e1;
#pragma unroll
      for (int jj = 0; jj < 4; ++jj) {
        e0[jj] = __builtin_amdgcn_exp2f(s[2 * s2][jj]);
        e1[jj] = __builtin_amdgcn_exp2f(s[2 * s2 + 1][jj]);
      }
      u32x4 w;
      w.x = pk_bf16(e0[0], e0[1]); w.y = pk_bf16(e0[2], e0[3]); w.z = pk_bf16(e1[0], e1[1]); w.w = pk_bf16(e1[2], e1[3]);
      const bf16x8 pf = __builtin_bit_cast(bf16x8, w);
      const bf16_t* vb = (half == 0) ? (sVc + (c * 64 + s2 * 32) * LDT) : (sVl + ((rs - rs0 + 2 * c + s2) * 64 + ks) * LDT);
#pragma unroll
      for (int dt = 0; dt < 4; ++dt) {
        const bf16_t* vp = vb + (4 * fq + (fr >> 2)) * LDT + dt * 16 + 4 * (fr & 3);
        const bf16x8 vf = cat8(tr_read(vp), tr_read(vp + 16 * LDT));
        o[dt] = mfma16(vf, pf, o[dt]);
      }
      lacc = mfma16(ones, pf, lacc);
    }
  }
  const float inv = 1.f / lacc[0];
#pragma unroll
  for (int dt = 0; dt < 4; ++dt) store_bf16x4(p.big + OFF_ON + qrow * 512 + h * 64 + dt * 16 + 4 * fq, o[dt] * inv);
  __syncthreads();
}

__global__ void __launch_bounds__(512) fwd_megakernel(Params p) {
  cg::grid_group grid = cg::this_grid();
  __shared__ __attribute__((aligned(16))) unsigned char lds_raw[LDS_BYTES];
  __shared__ float srpb[480];
  bf16_t* lds = (bf16_t*)lds_raw;
  float* ldsf = (float*)lds_raw;
  PG8_LAS unsigned char* glds = (PG8_LAS unsigned char*)lds_raw;
  const int G = gridDim.x, bid = blockIdx.x;
  using namespace pg8;
  __shared__ __attribute__((aligned(16))) unsigned xb_st[4];
  if (threadIdx.x < 4) xb_st[threadIdx.x] = 0u;
  __syncthreads();
  const XcdBarrier xb = xcd_barrier_post(p.bar, (volatile LAS unsigned*)xb_st);

  phase0(p, ldsf);
  if (p.never) grid.sync();
  xcd_barrier(xb);
  row_pass<1>(p);
  xcd_barrier(xb);
  { SubOrder S; S.init(TA / 256, 22, 0, 0, WGM_UP); gemm_phase(glds, Gemm{p.H, p.W13a, TA, 5632, 1024}, S, EpiSwiglu{p.big + OFF_U}); }
  { const int r = (TA / 256 * 22) % G; convert_w2a(p, ldsf, r); }
  xcd_barrier(xb);
  { SubOrder S; S.init(TL / 256, 4, 0, 0, WGM_N4); gemm_phase(glds, Gemm{p.big + OFF_U, p.W2a, TL, 1024, DFF}, S, EpiStoreSsq{p.big + OFF_Y, p.ssq + 0 * TA}); }
  { ShiftOrder S{TL / 256, 0, 64}; gemm_phase(glds, Gemm{p.big + OFF_U, p.W2a, TA, 1024, DFF / 2, DFF, DFF}, S, EpiStoreF32{p.xc, TL}); }
  { ShiftOrder S{TL / 256, 64, 64}; gemm_phase(glds, Gemm{p.big + OFF_U + DFF / 2, p.W2a + DFF / 2, TA, 1024, DFF / 2, DFF, DFF}, S, EpiStoreF32{p.yc1, TL}); }
  convert_rest(p, ldsf, 128 < G ? 128 : 0);
  xcd_barrier(xb);
  row_pass<2>(p);
  xcd_barrier(xb);
  { ProjOrder S; S.init(); gemm_phase(glds, Gemm{p.H, p.Win, TA, NPROJP, 1024}, S, EpiProj{p.big, p.b_gate, p.ropecs, p.ssq + 1 * TA, p.ssq + 2 * TA}); }
  xcd_barrier(xb);
  { SubOrder S; S.init(TL / 256, 3, 0, 0, WGM_N4); gemm_phase(glds, Gemm{p.big + OFF_CQ, p.Wuq, TL, 768, 768}, S, EpiQup{p.big + OFF_QM, p.ssq + 1 * TA, p.ropecs}); }
  { KvOrder S; gemm_phase(glds, Gemm{p.big + OFF_CKV, p.Wukv, TA, 1024, 256}, S, EpiKVup{p.H, p.ssq + 2 * TA}); }
  xcd_barrier(xb);
  {
    const int xcd = bid & 7, loc = bid >> 3, per = G >> 3;
    for (int i = 0; (i * 8 + xcd) * per + loc < 1024; ++i) mla_unit(p, (i * 8 + xcd) * per + loc, lds);
    for (int i = 0; (i * 8 + xcd) * per + loc < 2048; ++i) na_unit(p, (i * 8 + xcd) * per + loc, lds, srpb);
  }
  xcd_barrier(xb);
  { SubOrder S; S.init(TL / 256, 4, 0, 0, WGM_N4); gemm_phase(glds, Gemm{p.big + OFF_ON, p.Wona, TL, 1024, 512}, S, EpiGate<false>{p.H, p.big + OFF_G, 0}); }
  { SubOrder S; S.init(TL / 256, 4, 0, 0, WGM_N4); gemm_phase(glds, Gemm{p.big + OFF_OM, p.Womla, TL, 1024, 512}, S, EpiGate<true>{p.H, p.big + OFF_G, 1024}); }
  xcd_barrier(xb);
  { SubOrder S; S.init(TL / 256, 4, 0, 0, WGM_N4); gemm_phase(glds, Gemm{p.H, p.Wout, TL, 1024, 1024}, S, EpiStoreSsq{p.big + OFF_Y2, p.ssq + 3 * TA}); }
  xcd_barrier(xb);
  row_pass<3>(p);
  xcd_barrier(xb);
  { SubOrder S; S.init(TL / 256, 22, 0, 0, WGM_UP); gemm_phase(glds, Gemm{p.H, p.W13b, TL, 5632, 1024}, S, EpiSwiglu{p.big + OFF_U}); }
  xcd_barrier(xb);
  { SubOrder S; S.init(TL / 256, 4, 0, 0, WGM_N4); gemm_phase(glds, Gemm{p.big + OFF_U, p.W2b, TL, 1024, DFF}, S, EpiStoreSsq{p.big + OFF_Y, p.ssq + 4 * TA}); }
  xcd_barrier(xb);
  row_pass<4>(p);
}

extern "C" void kernel_launch(void* const* d_in, const int* in_sizes, int n_in, void* d_out, int out_size, void* d_ws, size_t ws_size,
                              hipStream_t stream) {
  static int grid_blocks = 0;
  if (!grid_blocks) {
    int dev = 0, cus = 0, per_cu = 0;
    (void)hipGetDevice(&dev);
    (void)hipDeviceGetAttribute(&cus, hipDeviceAttributeMultiprocessorCount, dev);
    (void)hipOccupancyMaxActiveBlocksPerMultiprocessor(&per_cu, fwd_megakernel, NT, 0);
    if (per_cu > 1) per_cu = 1;
    grid_blocks = (cus * per_cu) & ~7;
  }
  Params p{};
  const float* const* in = (const float* const*)d_in;
  p.x = in[0]; p.c = in[1]; p.ctx = in[2]; p.c_ctx = in[3]; p.w_ada = in[4]; p.b_ada = in[5]; p.norm_g = in[6];
  p.f1w1 = in[7]; p.f1w3 = in[8]; p.f1w2 = in[9]; p.w_in = in[10]; p.b_gate = in[11]; p.g_q = in[12]; p.g_kv = in[13];
  p.w_uq = in[14]; p.w_ukv = in[15]; p.rpb = in[16]; p.w_o_na = in[17]; p.w_o_mla = in[18]; p.w_out = in[19];
  p.f2w1 = in[20]; p.f2w3 = in[21]; p.f2w2 = in[22];
  p.out = (float*)d_out;
  unsigned char* ws = (unsigned char*)d_ws;
  size_t off = 0;
  auto take = [&](size_t bytes) { size_t o = off; off += (bytes + 255) & ~(size_t)255; return ws + o; };
  p.bar = (unsigned*)take((size_t)XCD_BAR_WORDS * 4);
  p.mod = (float*)take((size_t)17 * 9216 * 4);
  p.ropecs = (float*)take(1024 * 4);
  p.ssq = (float*)take((size_t)5 * TA * 4);
  p.W13a = (bf16_t*)take((size_t)5632 * 1024 * 2);
  p.W2a = (bf16_t*)take((size_t)1024 * DFF * 2);
  p.Win = (bf16_t*)take((size_t)NPROJP * 1024 * 2);
  p.Wuq = (bf16_t*)take((size_t)768 * 768 * 2);
  p.Wukv = (bf16_t*)take((size_t)1024 * 256 * 2);
  p.Wona = (bf16_t*)take((size_t)1024 * 512 * 2);
  p.Womla = (bf16_t*)take((size_t)1024 * 512 * 2);
  p.Wout = (bf16_t*)take((size_t)1024 * 1024 * 2);
  p.W13b = (bf16_t*)take((size_t)5632 * 1024 * 2);
  p.W2b = (bf16_t*)take((size_t)1024 * DFF * 2);
  p.xc = (float*)take((size_t)TC * 1024 * 4);
  p.yc1 = (float*)take((size_t)TC * 1024 * 4);
  p.H = (bf16_t*)take((size_t)TA * 1024 * 2);
  p.big = (bf16_t*)take(BIG_ELEMS * 2);
  if (off > ws_size) { fprintf(stderr, "workspace too small: need %zu have %zu\n", off, ws_size); return; }
  (void)hipMemsetAsync(p.bar, 0, (size_t)XCD_BAR_WORDS * 4, stream);
  void* args[] = {&p};
  hipError_t e = hipLaunchCooperativeKernel((void*)fwd_megakernel, dim3(grid_blocks), dim3(NT), args, 0, stream);
  if (e != hipSuccess) fprintf(stderr, "cooperative launch failed: %s (grid %d)\n", hipGetErrorString(e), grid_blocks);
}
```

```cpp
#include <hip/hip_runtime.h>
#include <hip/hip_cooperative_groups.h>
#include <cstdint>
#include <cstdio>
namespace cg = cooperative_groups;

typedef unsigned short bf16_t;
typedef short bf16x8 __attribute__((ext_vector_type(8)));
typedef short s16x4 __attribute__((ext_vector_type(4)));
typedef float f32x4 __attribute__((ext_vector_type(4)));
typedef float f32x2 __attribute__((ext_vector_type(2)));
typedef unsigned u32x4 __attribute__((ext_vector_type(4)));
typedef unsigned u32x2 __attribute__((ext_vector_type(2)));
typedef __bf16 bf2_t __attribute__((ext_vector_type(2)));

#define DI __device__ __forceinline__

constexpr int NT = 512;
constexpr int NW = 8;
constexpr int TL = 32768;
constexpr int TC = 4096;
constexpr int TA = 36864;
constexpr int DFF = 2816;
constexpr int NPROJ = 4640;
constexpr int NPROJP = 4864;
constexpr int LDT = 72;
constexpr int LDV = 80;
constexpr int LDK = 104;
constexpr int LDS_BYTES = (256 + 576 + 256) * LDT * 2;
static_assert(LDS_BYTES >= 131072, "GEMM stage ring");
constexpr float RMS_EPS = 1e-6f;
constexpr float LOG2E = 1.4426950408889634f;

struct Params {
  const float *x, *c, *ctx, *c_ctx, *w_ada, *b_ada, *norm_g, *f1w1, *f1w3, *f1w2, *w_in, *b_gate, *g_q, *g_kv,
      *w_uq, *w_ukv, *rpb, *w_o_na, *w_o_mla, *w_out, *f2w1, *f2w3, *f2w2;
  float* out;
  long never;
  unsigned* bar;
  float* mod;
  float* ropecs;
  float* ssq;
  bf16_t *W13a, *W2a, *Win, *Wuq, *Wukv, *Wona, *Womla, *Wout, *W13b, *W2b;
  float* xc;
  float* yc1;
  bf16_t* H;
  bf16_t* big;
};

constexpr size_t OFF_U = 0;
constexpr size_t OFF_Y = (size_t)TA * DFF;
constexpr size_t OFF_QA = 0;
constexpr size_t OFF_KA = OFF_QA + (size_t)TL * 512;
constexpr size_t OFF_VA = OFF_KA + (size_t)TA * 512;
constexpr size_t OFF_CQ = OFF_VA + (size_t)TA * 512;
constexpr size_t OFF_CKV = OFF_CQ + (size_t)TL * 768;
constexpr size_t OFF_KR = OFF_CKV + (size_t)TA * 256;
constexpr size_t OFF_G = OFF_KR + (size_t)TA * 32;
constexpr size_t OFF_QM = OFF_G + (size_t)TL * 2048;
constexpr size_t BIG_ELEMS = OFF_QM + (size_t)TL * 768;
constexpr size_t OFF_OM = OFF_CQ;
constexpr size_t OFF_ON = OFF_OM + (size_t)TL * 512;
static_assert(OFF_ON + (size_t)TL * 512 <= OFF_KR, "NA output must fit before KR");
constexpr size_t OFF_Y2 = OFF_KA;

DI int ltid() { int t = threadIdx.x; asm volatile("" : "+v"(t)); return t; }
DI unsigned pk_bf16(float lo, float hi) {
  f32x2 v = {lo, hi};
  bf2_t r = __builtin_convertvector(v, bf2_t);
  return __builtin_bit_cast(unsigned, r);
}
DI void store_bf16x4(bf16_t* p, f32x4 v) {
  u32x2 w; w.x = pk_bf16(v[0], v[1]); w.y = pk_bf16(v[2], v[3]);
  *(u32x2*)p = w;
}
DI f32x4 load_bf16x4(const bf16_t* p) {
  const u32x2 w = *(const u32x2*)p;
  return (f32x4){__uint_as_float(w.x << 16), __uint_as_float(w.x & 0xffff0000u), __uint_as_float(w.y << 16), __uint_as_float(w.y & 0xffff0000u)};
}
DI f32x4 mfma16(bf16x8 a, bf16x8 b, f32x4 c) { return __builtin_amdgcn_mfma_f32_16x16x32_bf16(a, b, c, 0, 0, 0); }
DI s16x4 tr_read(const bf16_t* p) {
  return __builtin_amdgcn_ds_read_tr16_b64_v4i16((__attribute__((address_space(3))) s16x4*)p);
}
DI bf16x8 cat8(s16x4 lo, s16x4 hi) { return __builtin_shufflevector(lo, hi, 0, 1, 2, 3, 4, 5, 6, 7); }
DI float wave_sum(float v) {
  v += __shfl_xor(v, 32); v += __shfl_xor(v, 16); v += __shfl_xor(v, 8);
  v += __shfl_xor(v, 4); v += __shfl_xor(v, 2); v += __shfl_xor(v, 1);
  return v;
}

DI f32x4 rope4(f32x4 v, int fq, int pos, const float* ropecs) {
  f32x4 o;
#pragma unroll
  for (int j = 0; j < 4; ++j) {
    const float other = __shfl_xor(v[j], 32);
    const int i = (4 * fq + j) & 7;
    const float cs = ropecs[pos * 8 + i], sn = ropecs[512 + pos * 8 + i];
    o[j] = (fq < 2) ? (v[j] * cs - other * sn) : (v[j] * cs + other * sn);
  }
  return o;
}

DI f32x4 rope4p(f32x4 v, int n, int fq, int pos_row, int pos_col, const float* ropecs) {
  const int pos = (fq >> 1) ? pos_col : pos_row;
  f32x4 o;
#pragma unroll
  for (int j = 0; j < 4; ++j) {
    const float other = __shfl_xor(v[j], 16);
    const int i = 4 * n + j;
    const float cs = ropecs[pos * 8 + i], sn = ropecs[512 + pos * 8 + i];
    o[j] = ((fq & 1) == 0) ? (v[j] * cs - other * sn) : (v[j] * cs + other * sn);
  }
  return o;
}
DI void store_bf16x8(bf16_t* p, f32x4 a, f32x4 b) {
  u32x4 w; w.x = pk_bf16(a[0], a[1]); w.y = pk_bf16(a[2], a[3]); w.z = pk_bf16(b[0], b[1]); w.w = pk_bf16(b[2], b[3]);
  *(u32x4*)p = w;
}
DI void load_bf16x8(const bf16_t* p, f32x4& a, f32x4& b) {
  const u32x4 w = *(const u32x4*)p;
  a = (f32x4){__uint_as_float(w.x << 16), __uint_as_float(w.x & 0xffff0000u), __uint_as_float(w.y << 16), __uint_as_float(w.y & 0xffff0000u)};
  b = (f32x4){__uint_as_float(w.z << 16), __uint_as_float(w.z & 0xffff0000u), __uint_as_float(w.w << 16), __uint_as_float(w.w & 0xffff0000u)};
}

#ifndef WGM_UP
#define WGM_UP 2
#endif
#ifndef WGM_N4
#define WGM_N4 4
#endif
#ifndef WGM_PROJ
#define WGM_PROJ 4
#endif
namespace pg8 {
#define PG8_LAS __attribute__((address_space(3)))
constexpr int BM = 256, BK = 64, HALF = 128, HTB = HALF * BK * 2, STAGE_BYTES = 8 * HTB, NXCD = 8, WGM = 4;
__host__ __device__ __forceinline__ int lds_byte(int r, int c) { const int st = (r >> 4) * 2 + (c >> 5), rr = r & 15, cc = c & 31, ob = rr * 64 + cc * 2; return st * 1024 + (ob ^ (((ob >> 9) & 1) << 5)); }
__host__ __device__ __forceinline__ void stage_rc(int b, int& R, int& C) { const int st = b / 1024, sb = b % 1024, swz = sb ^ (((sb >> 9) & 1) << 5); R = (st >> 1) * 16 + swz / 64; C = (st & 1) * 32 + (swz % 64) / 2; }
__host__ __device__ __forceinline__ int perm32(int rho) { const int n = rho >> 4, i = rho & 15; return 8 * (i >> 2) + 4 * n + (i & 3); }

struct Unit { int pm, pn; };
struct Gemm { const bf16_t* A; const bf16_t* Bt; int M, N, K; int lda = 0, ldb = 0; };

struct StaticOrder {
    int nM, nN, nwg, G, c, wgm = WGM;
    __host__ __device__ void init(int M, int N, int G_, int c_) { nM = M / BM; nN = N / BM; nwg = nM * nN; G = G_; c = c_; }
    __host__ __device__ bool next(int i, Unit& u) const {
        const long L = (long)i * G + c; if (L >= nwg) return false;
        int wgid = (int)L; { const int q = nwg / NXCD, r = nwg % NXCD, xcd = wgid % NXCD, off = wgid / NXCD; wgid = (xcd < r ? xcd * (q + 1) : r * (q + 1) + (xcd - r) * q) + off; }
        const int nig = wgm * nN, gid = wgid / nig, fm = gid * wgm, gsz = (nM - fm) < wgm ? (nM - fm) : wgm;
        u.pm = fm + ((wgid % nig) % gsz); u.pn = (wgid % nig) / gsz; return true;
    }
    __device__ __forceinline__ void a_ready(const Unit&) const {}
    __device__ __forceinline__ void done(const Unit&) const {}
};
template <class Epi, class Sched, bool ALIGN_EPI = true, bool SP2 = true>
__device__ __forceinline__ void gemm_phase(PG8_LAS unsigned char* lds, const Gemm g, const Sched& S, const Epi& E) {
    int tid = threadIdx.x; asm volatile("" : "+v"(tid));
    const int wid = __builtin_amdgcn_readfirstlane(tid >> 6), lane = tid & 63, wr = wid >> 2, wc = wid & 3, fr = lane & 15, fq = lane >> 4;
    int K = g.K; asm volatile("" : "+s"(K)); const int nt = K / BK;
    int lda = g.lda ? g.lda : g.K, ldb = g.ldb ? g.ldb : g.K; asm volatile("" : "+s"(lda), "+s"(ldb));
    unsigned voffA[2], voffB[2];
#pragma unroll
    for (int i = 0; i < 2; ++i) { int R, C; stage_rc(tid * 16 + i * 8192, R, C); const int Rb = Epi::PERM ? ((R & ~31) + perm32(R & 31)) : R;
        voffA[i] = (unsigned)(R * lda + C) * 2u; voffB[i] = (unsigned)(Rb * ldb + C) * 2u; }
    const size_t kstep = (size_t)(BK * 2);
    const size_t hstepA = (size_t)HALF * lda * 2, hstepB = (size_t)HALF * ldb * 2;
    const size_t tstepA = 2 * hstepA, tstepB = 2 * hstepB;
    const unsigned ldsw = (unsigned)wid * 1024u;
    const int aoff = lds_byte(wr * 64 + fr, fq * 8), boff = lds_byte(wc * 32 + fr, fq * 8);
#define PG8_SA(b, h) (((b) * 2 + (h)) * HTB)
#define PG8_SB(b, h) ((4 + (b) * 2 + (h)) * HTB)
#define PG8_STAGE(bufoff, gbase, voff) do { _Pragma("unroll") for (int _i = 0; _i < 2; ++_i) \
        __builtin_amdgcn_global_load_lds((const unsigned*)((const char*)(gbase) + (voff)[_i]), (PG8_LAS unsigned*)(lds + (bufoff) + ldsw + _i * 8192), 16, 0, 0); } while (0)
#define PG8_LDA(dst, b, h) do { _Pragma("unroll") for (int m = 0; m < 4; ++m) _Pragma("unroll") for (int k = 0; k < 2; ++k) dst[m][k] = *(const PG8_LAS bf16x8*)(lds + PG8_SA(b, h) + aoff + m * 2048 + k * 1024); } while (0)
#define PG8_LDB(dst, b, h) do { _Pragma("unroll") for (int n = 0; n < 2; ++n) _Pragma("unroll") for (int k = 0; k < 2; ++k) dst[n][k] = *(const PG8_LAS bf16x8*)(lds + PG8_SB(b, h) + boff + n * 2048 + k * 1024); } while (0)
#define PG8_MMA(ai, bj, At, Bt) do { __builtin_amdgcn_s_setprio(1); _Pragma("unroll") for (int m = 0; m < 4; ++m) _Pragma("unroll") for (int n = 0; n < 2; ++n) _Pragma("unroll") for (int k = 0; k < 2; ++k) \
        acc[ai][bj][m][n] = __builtin_amdgcn_mfma_f32_16x16x32_bf16(Bt[n][k], At[m][k], acc[ai][bj][m][n], 0, 0, 0); __builtin_amdgcn_s_setprio(0); } while (0)
#define PG8_WAIT_V(n) asm volatile("s_waitcnt vmcnt(" #n ")" ::: "memory")
#define PG8_WAIT_L(n) asm volatile("s_waitcnt lgkmcnt(" #n ")" ::: "memory")
#define PG8_BAR __builtin_amdgcn_s_barrier()
#define PG8_SCHED __builtin_amdgcn_sched_barrier(0)
    Unit cur, nxt; int ui = 0;
    if (!S.next(0, cur)) return;
    f32x4 acc[2][2][4][2];
#pragma unroll
    for (int a = 0; a < 2; ++a)
#pragma unroll
        for (int b = 0; b < 2; ++b)
#pragma unroll
            for (int m = 0; m < 4; ++m)
#pragma unroll
                for (int n = 0; n < 2; ++n) acc[a][b][m][n] = (f32x4){0.f, 0.f, 0.f, 0.f};
    bf16x8 At[4][2], B0[2][2], B1[2][2];
    const char* cA = (const char*)g.A + (size_t)cur.pm * tstepA; const char* cB = (const char*)g.Bt + (size_t)cur.pn * tstepB;
    S.a_ready(cur);
    if constexpr (SP2) {
        PG8_STAGE(PG8_SB(0, 0), cB, voffB); PG8_STAGE(PG8_SB(0, 1), cB + hstepB, voffB); PG8_STAGE(PG8_SA(0, 0), cA, voffA); PG8_STAGE(PG8_SA(0, 1), cA + hstepA, voffA);
        if (wr == 1) PG8_BAR;
        PG8_WAIT_V(2); PG8_BAR;
        PG8_STAGE(PG8_SB(1, 0), cB + kstep, voffB); PG8_STAGE(PG8_SA(1, 0), cA + kstep, voffA); PG8_STAGE(PG8_SB(1, 1), cB + hstepB + kstep, voffB);
        PG8_WAIT_V(6); PG8_BAR;
    } else {
        PG8_STAGE(PG8_SB(0, 0), cB, voffB); PG8_STAGE(PG8_SA(0, 0), cA, voffA); PG8_STAGE(PG8_SB(0, 1), cB + hstepB, voffB); PG8_STAGE(PG8_SA(0, 1), cA + hstepA, voffA);
        if (wr == 1) PG8_BAR;
        PG8_WAIT_V(4); PG8_BAR;
        PG8_STAGE(PG8_SB(1, 0), cB + kstep, voffB); PG8_STAGE(PG8_SA(1, 0), cA + kstep, voffA); PG8_STAGE(PG8_SB(1, 1), cB + hstepB + kstep, voffB);
        PG8_WAIT_V(6); PG8_BAR;
    }
    for (;;) {
        const bool has_next = S.next(ui + 1, nxt);
        const char* nA = has_next ? (const char*)g.A + (size_t)nxt.pm * tstepA : cA; const char* nB = has_next ? (const char*)g.Bt + (size_t)nxt.pn * tstepB : cB;
        for (int t = 0; t < nt; t += 2) {
            const bool last = (t == nt - 2);
            const char* a1 = cA + (size_t)(t + 1) * kstep;
            const char* a2 = last ? nA : cA + (size_t)(t + 2) * kstep; const char* b2 = last ? nB : cB + (size_t)(t + 2) * kstep;
            const char* a3 = a2 + kstep; const char* b3 = b2 + kstep;
            if (last && has_next) S.a_ready(nxt);
            if constexpr (SP2) {
            PG8_LDB(B0, 0, 0); PG8_LDB(B1, 0, 1); PG8_SCHED; PG8_LDA(At, 0, 0); PG8_STAGE(PG8_SA(1, 1), a1 + hstepA, voffA);
            PG8_WAIT_V(8); PG8_WAIT_L(0); PG8_BAR; PG8_MMA(0, 0, At, B0); PG8_MMA(0, 1, At, B1); PG8_BAR; PG8_SCHED;
            PG8_LDA(At, 0, 1); PG8_STAGE(PG8_SB(0, 0), b2, voffB); PG8_STAGE(PG8_SB(0, 1), b2 + hstepB, voffB); PG8_STAGE(PG8_SA(0, 0), a2, voffA);
            PG8_WAIT_V(8); PG8_WAIT_L(0); PG8_BAR; PG8_MMA(1, 0, At, B0); PG8_MMA(1, 1, At, B1); PG8_BAR; PG8_SCHED;
            PG8_LDB(B0, 1, 0); PG8_LDB(B1, 1, 1); PG8_SCHED; PG8_LDA(At, 1, 0); PG8_STAGE(PG8_SA(0, 1), a2 + hstepA, voffA);
            PG8_WAIT_V(8); PG8_WAIT_L(0); PG8_BAR; PG8_MMA(0, 0, At, B0); PG8_MMA(0, 1, At, B1); PG8_BAR; PG8_SCHED;
            PG8_LDA(At, 1, 1); PG8_STAGE(PG8_SB(1, 0), b3, voffB); PG8_STAGE(PG8_SB(1, 1), b3 + hstepB, voffB); PG8_STAGE(PG8_SA(1, 0), a3, voffA);
            PG8_WAIT_V(8); PG8_WAIT_L(0); PG8_BAR; PG8_MMA(1, 0, At, B0); PG8_MMA(1, 1, At, B1); PG8_BAR; PG8_SCHED;
            } else {
            PG8_LDB(B0, 0, 0); PG8_SCHED; PG8_LDA(At, 0, 0); PG8_STAGE(PG8_SA(1, 1), a1 + hstepA, voffA);
            PG8_WAIT_L(8); PG8_BAR; PG8_WAIT_L(0); PG8_MMA(0, 0, At, B0); PG8_BAR; PG8_SCHED;
            PG8_LDB(B1, 0, 1); PG8_STAGE(PG8_SB(0, 0), b2, voffB);
            PG8_BAR; PG8_WAIT_L(0); PG8_MMA(0, 1, At, B1); PG8_BAR;
            PG8_LDA(At, 0, 1); PG8_STAGE(PG8_SA(0, 0), a2, voffA);
            PG8_BAR; PG8_WAIT_L(0); PG8_MMA(1, 0, At, B0); PG8_BAR; PG8_SCHED;
            PG8_STAGE(PG8_SB(0, 1), b2 + hstepB, voffB);
            PG8_WAIT_V(6); PG8_BAR; PG8_MMA(1, 1, At, B1); PG8_BAR;
            PG8_LDB(B0, 1, 0); PG8_SCHED; PG8_LDA(At, 1, 0); PG8_STAGE(PG8_SA(0, 1), a2 + hstepA, voffA);
            PG8_WAIT_L(8); PG8_BAR; PG8_WAIT_L(0); PG8_MMA(0, 0, At, B0); PG8_BAR; PG8_SCHED;
            PG8_LDB(B1, 1, 1); PG8_STAGE(PG8_SB(1, 0), b3, voffB);
            PG8_BAR; PG8_WAIT_L(0); PG8_MMA(0, 1, At, B1); PG8_BAR;
            PG8_LDA(At, 1, 1); PG8_STAGE(PG8_SA(1, 0), a3, voffA);
            PG8_BAR; PG8_WAIT_L(0); PG8_MMA(1, 0, At, B0); PG8_BAR; PG8_SCHED;
            PG8_STAGE(PG8_SB(1, 1), b3 + hstepB, voffB);
            PG8_WAIT_V(6); PG8_BAR; PG8_MMA(1, 1, At, B1); PG8_BAR;
            }
        }
        if constexpr (ALIGN_EPI) { if (wr == 0) PG8_BAR; }
        if constexpr (!Epi::AFTER_DRAIN) { E(acc, cur, wr, wc, fr, fq); S.done(cur); }
        if (!has_next) break;
#pragma unroll
        for (int a = 0; a < 2; ++a)
#pragma unroll
            for (int b = 0; b < 2; ++b)
#pragma unroll
                for (int m = 0; m < 4; ++m)
#pragma unroll
                    for (int n = 0; n < 2; ++n) acc[a][b][m][n] = (f32x4){0.f, 0.f, 0.f, 0.f};
        cur = nxt; cA = nA; cB = nB; ++ui;
        if constexpr (ALIGN_EPI) { if (wr == 1) PG8_BAR; }
    }
    PG8_WAIT_V(0);
    if constexpr (!ALIGN_EPI) { if (wr == 0) PG8_BAR; }
    PG8_BAR;
    if constexpr (Epi::AFTER_DRAIN) { E.fused(acc, cur, wr, wc, fr, fq, lds, wid, lane); S.done(cur); }
#undef PG8_SA
#undef PG8_SB
#undef PG8_STAGE
#undef PG8_LDA
#undef PG8_LDB
#undef PG8_MMA
#undef PG8_WAIT_V
#undef PG8_WAIT_L
#undef PG8_BAR
#undef PG8_SCHED
}
struct SubOrder {
  StaticOrder so; int pm0, pn0;
  __device__ void init(int nM, int nN, int pm0_, int pn0_, int wgm_ = WGM) { so.init(nM * BM, nN * BM, gridDim.x, blockIdx.x); so.wgm = wgm_; pm0 = pm0_; pn0 = pn0_; }
  __device__ bool next(int i, Unit& u) const { if (!so.next(i, u)) return false; u.pm += pm0; u.pn += pn0; return true; }
  __device__ __forceinline__ void a_ready(const Unit&) const {}
  __device__ __forceinline__ void done(const Unit&) const {}
};
struct ProjOrder {
  StaticOrder so; int G, c;
  __device__ void init() { G = gridDim.x; c = blockIdx.x; so.init(TL, NPROJP, G, c); so.wgm = WGM_PROJ; }
  __device__ bool next(int i, Unit& u) const {
    const long L = (long)i * G + c;
    if (L < 128 * 19) return so.next(i, u);
    const int idx = (int)L - 128 * 19;
    if (idx >= 96) return false;
    const int k = idx % 6;
    u.pm = 128 + idx / 6; u.pn = (k < 4) ? (2 + k) : (5 + k);
    return true;
  }
  __device__ __forceinline__ void a_ready(const Unit&) const {}
  __device__ __forceinline__ void done(const Unit&) const {}
};

struct ShiftOrder {
  int pm0, c0, n;
  __device__ bool next(int i, Unit& u) const {
    const int idx = (int)blockIdx.x - c0;
    if (i > 0 || idx < 0 || idx >= n) return false;
    u.pm = pm0 + (idx >> 2); u.pn = idx & 3;
    return true;
  }
  __device__ __forceinline__ void a_ready(const Unit&) const {}
  __device__ __forceinline__ void done(const Unit&) const {}
};
struct KvOrder {
  __device__ bool next(int i, Unit& u) const {
    const int c = blockIdx.x;
    int idx;
    if (gridDim.x != 256) { idx = i * (int)gridDim.x + c; if (idx >= 576) return false; }
    else if (c >= 128) { if (i >= 4) return false; idx = (c - 128) * 4 + i; }
    else if (c < 64) { if (i >= 1) return false; idx = 512 + c; }
    else return false;
    u.pm = idx >> 2; u.pn = idx & 3;
    return true;
  }
  __device__ __forceinline__ void a_ready(const Unit&) const {}
  __device__ __forceinline__ void done(const Unit&) const {}
};
struct EpiStoreF32 {
  static constexpr bool PERM = true, AFTER_DRAIN = false;
  float* Yp; int row0;
  __device__ __forceinline__ void operator()(const f32x4 (&acc)[2][2][4][2], const Unit& u, int wr, int wc, int fr, int fq) const {
    asm volatile("" : "+v"(fr), "+v"(fq));
#pragma unroll
    for (int ai = 0; ai < 2; ++ai)
#pragma unroll
      for (int m = 0; m < 4; ++m) {
        const size_t row = (size_t)u.pm * BM + ai * HALF + wr * 64 + m * 16 + fr - row0;
#pragma unroll
        for (int bj = 0; bj < 2; ++bj) {
          float* d = Yp + row * 1024 + u.pn * BM + bj * HALF + wc * 32 + 8 * fq;
          *(f32x4*)d = acc[ai][bj][m][0]; *(f32x4*)(d + 4) = acc[ai][bj][m][1];
        }
      }
  }
};

struct EpiSwiglu {
  static constexpr bool PERM = true, AFTER_DRAIN = false;
  bf16_t* U;
  __device__ __forceinline__ void operator()(const f32x4 (&acc)[2][2][4][2], const Unit& u, int wr, int wc, int fr, int fq) const {
    asm volatile("" : "+v"(fr), "+v"(fq));
#pragma unroll
    for (int ai = 0; ai < 2; ++ai)
#pragma unroll
      for (int m = 0; m < 4; ++m) {
        const size_t row = (size_t)u.pm * BM + ai * HALF + wr * 64 + m * 16 + fr;
        f32x4 v[2];
#pragma unroll
        for (int n = 0; n < 2; ++n) {
          const f32x4 a = acc[ai][0][m][n], b = acc[ai][1][m][n];
#pragma unroll
          for (int j = 0; j < 4; ++j) v[n][j] = a[j] * __builtin_amdgcn_rcpf(1.f + __builtin_amdgcn_exp2f(-LOG2E * a[j])) * b[j];
        }
        u32x4 w; w.x = pk_bf16(v[0][0], v[0][1]); w.y = pk_bf16(v[0][2], v[0][3]); w.z = pk_bf16(v[1][0], v[1][1]); w.w = pk_bf16(v[1][2], v[1][3]);
        *(u32x4*)(U + row * DFF + u.pn * 128 + wc * 32 + 8 * fq) = w;
      }
  }
};

struct EpiStoreSsq {
  static constexpr bool PERM = true, AFTER_DRAIN = false;
  bf16_t* Y; float* ssq;
  __device__ __forceinline__ void operator()(const f32x4 (&acc)[2][2][4][2], const Unit& u, int wr, int wc, int fr, int fq) const {
    asm volatile("" : "+v"(fr), "+v"(fq));
#pragma unroll
    for (int ai = 0; ai < 2; ++ai)
#pragma unroll
      for (int m = 0; m < 4; ++m) {
        const size_t row = (size_t)u.pm * BM + ai * HALF + wr * 64 + m * 16 + fr;
        float s = 0.f;
#pragma unroll
        for (int bj = 0; bj < 2; ++bj) {
          const f32x4 v0 = acc[ai][bj][m][0], v1 = acc[ai][bj][m][1];
          s += v0[0] * v0[0] + v0[1] * v0[1] + v0[2] * v0[2] + v0[3] * v0[3] + v1[0] * v1[0] + v1[1] * v1[1] + v1[2] * v1[2] + v1[3] * v1[3];
          u32x4 w; w.x = pk_bf16(v0[0], v0[1]); w.y = pk_bf16(v0[2], v0[3]); w.z = pk_bf16(v1[0], v1[1]); w.w = pk_bf16(v1[2], v1[3]);
          *(u32x4*)(Y + row * 1024 + u.pn * BM + bj * HALF + wc * 32 + 8 * fq) = w;
        }
        s += __shfl_xor(s, 16); s += __shfl_xor(s, 32);
        if (fq == 0) atomicAdd(ssq + row, s);
      }
  }
};

struct EpiProj {
  static constexpr bool PERM = true, AFTER_DRAIN = false;
  bf16_t* big; const float* b_gate; const float* ropecs; float* ssq_q; float* ssq_kv;
  __device__ __forceinline__ void operator()(const f32x4 (&acc)[2][2][4][2], const Unit& u, int wr, int wc, int fr, int fq) const {
    asm volatile("" : "+v"(fr), "+v"(fq));
    const int pn = u.pn;
    const bool latent = u.pm < 128;
    if (pn < 6) {
      bf16_t* dst = big + ((pn < 2) ? OFF_QA : (pn < 4) ? OFF_KA : OFF_VA);
      const float sc = (pn < 2) ? 0.125f * LOG2E : 1.f;
      const int c0 = (pn & 1) * 256;
#pragma unroll
      for (int ai = 0; ai < 2; ++ai)
#pragma unroll
        for (int m = 0; m < 4; ++m) {
          const size_t row = (size_t)u.pm * BM + ai * HALF + wr * 64 + m * 16 + fr;
#pragma unroll
          for (int bj = 0; bj < 2; ++bj) store_bf16x8(dst + row * 512 + c0 + bj * HALF + wc * 32 + 8 * fq, acc[ai][bj][m][0] * sc, acc[ai][bj][m][1] * sc);
          asm volatile("" ::: "memory");
        }
    } else if (pn < 10) {
      const bool isq = pn < 9;
      bf16_t* dst = big + (isq ? OFF_CQ : OFF_CKV);
      const int ld = isq ? 768 : 256, c0 = isq ? (pn - 6) * 256 : 0;
      float* ssq = isq ? ssq_q : ssq_kv;
#pragma unroll
      for (int ai = 0; ai < 2; ++ai)
#pragma unroll
        for (int m = 0; m < 4; ++m) {
          const size_t row = (size_t)u.pm * BM + ai * HALF + wr * 64 + m * 16 + fr;
          float s = 0.f;
#pragma unroll
          for (int bj = 0; bj < 2; ++bj) {
            const f32x4 v0 = acc[ai][bj][m][0], v1 = acc[ai][bj][m][1];
            s += v0[0] * v0[0] + v0[1] * v0[1] + v0[2] * v0[2] + v0[3] * v0[3] + v1[0] * v1[0] + v1[1] * v1[1] + v1[2] * v1[2] + v1[3] * v1[3];
            store_bf16x8(dst + row * ld + c0 + bj * HALF + wc * 32 + 8 * fq, v0, v1);
          }
          s += __shfl_xor(s, 16); s += __shfl_xor(s, 32);
          if (fq == 0) atomicAdd(ssq + row, s);
          asm volatile("" ::: "memory");
        }
    } else {
#pragma unroll
      for (int bj = 0; bj < 2; ++bj) {
        const int colg = pn * BM + bj * HALF + wc * 32;
        if (colg == 2560) {
#pragma unroll
          for (int ai = 0; ai < 2; ++ai)
#pragma unroll
            for (int m = 0; m < 4; ++m) {
              const int row = u.pm * BM + ai * HALF + wr * 64 + m * 16 + fr;
              f32x4 v0 = acc[ai][bj][m][0], v1 = acc[ai][bj][m][1];
              if (latent) {
                const int t = row & 2047;
                v0 = rope4p(v0, 0, fq, t >> 6, t & 63, ropecs);
                v1 = rope4p(v1, 1, fq, t >> 6, t & 63, ropecs);
              }
              store_bf16x8(big + OFF_KR + (size_t)row * 32 + 8 * fq, v0, v1);
              asm volatile("" ::: "memory");
            }
        } else if (colg < NPROJ && latent) {
          const int gc = colg - 2592 + 8 * fq;
          const f32x4 bg0 = *(const f32x4*)(b_gate + gc), bg1 = *(const f32x4*)(b_gate + gc + 4);
#pragma unroll
          for (int ai = 0; ai < 2; ++ai)
#pragma unroll
            for (int m = 0; m < 4; ++m) {
              const int row = u.pm * BM + ai * HALF + wr * 64 + m * 16 + fr;
              f32x4 v0 = acc[ai][bj][m][0] + bg0, v1 = acc[ai][bj][m][1] + bg1;
#pragma unroll
              for (int j = 0; j < 4; ++j) {
                v0[j] = __builtin_amdgcn_rcpf(1.f + __builtin_amdgcn_exp2f(-LOG2E * v0[j]));
                v1[j] = __builtin_amdgcn_rcpf(1.f + __builtin_amdgcn_exp2f(-LOG2E * v1[j]));
              }
              store_bf16x8(big + OFF_G + (size_t)row * 2048 + gc, v0, v1);
              asm volatile("" ::: "memory");
            }
        }
      }
    }
  }
};

struct EpiQup {
  static constexpr bool PERM = true, AFTER_DRAIN = false;
  bf16_t* QM; const float* ssq_q; const float* ropecs;
  __device__ __forceinline__ void operator()(const f32x4 (&acc)[2][2][4][2], const Unit& u, int wr, int wc, int fr, int fq) const {
    asm volatile("" : "+v"(fr), "+v"(fq));
#pragma unroll
    for (int ai = 0; ai < 2; ++ai)
#pragma unroll
      for (int m = 0; m < 4; ++m) {
        const int row = u.pm * BM + ai * HALF + wr * 64 + m * 16 + fr;
        const float rs = rsqrtf(ssq_q[row] * (1.f / 768.f) + RMS_EPS) * (0.10206207261596575f * LOG2E);
        const int t = row & 2047;
#pragma unroll
        for (int bj = 0; bj < 2; ++bj) {
          const int colg = u.pn * BM + bj * HALF + wc * 32;
          f32x4 v0 = acc[ai][bj][m][0] * rs, v1 = acc[ai][bj][m][1] * rs;
          if (colg % 96 == 64) {
            v0 = rope4p(v0, 0, fq, t >> 6, t & 63, ropecs);
            v1 = rope4p(v1, 1, fq, t >> 6, t & 63, ropecs);
          }
          store_bf16x8(QM + (size_t)row * 768 + colg + 8 * fq, v0, v1);
        }
      }
  }
};

struct EpiKVup {
  static constexpr bool PERM = true, AFTER_DRAIN = false;
  bf16_t* KV; const float* ssq_kv;
  __device__ __forceinline__ void operator()(const f32x4 (&acc)[2][2][4][2], const Unit& u, int wr, int wc, int fr, int fq) const {
    asm volatile("" : "+v"(fr), "+v"(fq));
#pragma unroll
    for (int ai = 0; ai < 2; ++ai)
#pragma unroll
      for (int m = 0; m < 4; ++m) {
        const int row = u.pm * BM + ai * HALF + wr * 64 + m * 16 + fr;
        const float rs = rsqrtf(ssq_kv[row] * (1.f / 256.f) + RMS_EPS);
#pragma unroll
        for (int bj = 0; bj < 2; ++bj) store_bf16x8(KV + (size_t)row * 1024 + u.pn * BM + bj * HALF + wc * 32 + 8 * fq, acc[ai][bj][m][0] * rs, acc[ai][bj][m][1] * rs);
      }
  }
};

template <bool ADD>
struct EpiGate {
  static constexpr bool PERM = true, AFTER_DRAIN = false;
  bf16_t* Y1; const bf16_t* G; int gcol0;
  __device__ __forceinline__ void operator()(const f32x4 (&acc)[2][2][4][2], const Unit& u, int wr, int wc, int fr, int fq) const {
    asm volatile("" : "+v"(fr), "+v"(fq));
#pragma unroll
    for (int ai = 0; ai < 2; ++ai)
#pragma unroll
      for (int m = 0; m < 4; ++m) {
        const size_t row = (size_t)u.pm * BM + ai * HALF + wr * 64 + m * 16 + fr;
#pragma unroll
        for (int bj = 0; bj < 2; ++bj) {
          const int col = u.pn * BM + bj * HALF + wc * 32 + 8 * fq;
          f32x4 g0, g1; load_bf16x8(G + row * 2048 + gcol0 + col, g0, g1);
          f32x4 v0 = acc[ai][bj][m][0] * g0, v1 = acc[ai][bj][m][1] * g1;
          if (ADD) { f32x4 y0, y1; load_bf16x8(Y1 + row * 1024 + col, y0, y1); v0 = v0 + y0; v1 = v1 + y1; }
          store_bf16x8(Y1 + row * 1024 + col, v0, v1);
        }
      }
  }
};
}

#define LAS __attribute__((address_space(3)))
#define XB_TMO      128
#define XB_XCNT(j)  (256  + 64 * (j))
#define XB_XSUB(j)  (1280 + 64 * (j))
#define XB_XGEN(j)  (2304 + 64 * (j))
#define XB_TOP      3328
#define XB_TOPGEN   3392
#define XCD_BAR_WORDS 3456
#define XB_SPIN_CAP (1u << 18)

__device__ __forceinline__ unsigned xb_ld(unsigned* p)              { return __hip_atomic_load(p, __ATOMIC_RELAXED, __HIP_MEMORY_SCOPE_AGENT); }
__device__ __forceinline__ unsigned xb_add(unsigned* p, unsigned v) { return __hip_atomic_fetch_add(p, v, __ATOMIC_RELAXED, __HIP_MEMORY_SCOPE_AGENT); }
__device__ __forceinline__ unsigned xb_xcc_id() { return (unsigned)__builtin_amdgcn_s_getreg((3 << 11) | 20) & 0xFu; }
#define XB_SPIN(cond, bar) do { unsigned _sp = 0; while (cond) { __builtin_amdgcn_s_sleep(1); \
    if ((++_sp & 255u) == 0u) { if (xb_ld(&(bar)[XB_TMO])) break; if (_sp > XB_SPIN_CAP) { atomicAdd(&(bar)[XB_TMO], 1u); break; } } } } while (0)

struct XcdBarrier {
    unsigned* bar; unsigned x;
    volatile LAS unsigned* st;
};

__device__ __forceinline__ XcdBarrier xcd_barrier_post(unsigned* bar, volatile LAS unsigned* st) {
    XcdBarrier b; b.bar = bar; b.x = xb_xcc_id(); b.st = st;
    if (threadIdx.x == 0) (void)xb_add(&bar[XB_XCNT(b.x)], 1u);
    return b;
}
__device__ __forceinline__ void xcd_barrier_complete(unsigned* bar, unsigned x, unsigned& nloc, unsigned& nx) {
    const unsigned G = gridDim.x * gridDim.y * gridDim.z;
    unsigned sum, cnt, mine, sp = 0u;
    for (;;) {
        sum = 0u; cnt = 0u; mine = 0u;
#pragma unroll
        for (unsigned j = 0; j < 16; ++j) { const unsigned c = xb_ld(&bar[XB_XCNT(j)]); sum += c; cnt += (c > 0u) ? 1u : 0u; mine = (j == x) ? c : mine; }
        if (sum == G) break;
        __builtin_amdgcn_s_sleep(1);
        if ((++sp & 255u) == 0u) { if (xb_ld(&bar[XB_TMO])) break; if (sp > XB_SPIN_CAP) { atomicAdd(&bar[XB_TMO], 1u); break; } }
    }
    nloc = mine > 0u ? mine : 1u; nx = cnt > 0u ? cnt : 1u;
}

__device__ __forceinline__ void xcd_barrier(const XcdBarrier& b) {
    asm volatile("s_waitcnt vmcnt(0)" ::: "memory");
    __syncthreads();
    if (threadIdx.x == 0) {
        unsigned* bar = b.bar;
        __builtin_amdgcn_s_waitcnt(0);
        unsigned nloc = b.st[0], nx = b.st[1];
        if (nloc == 0u) { xcd_barrier_complete(bar, b.x, nloc, nx); b.st[0] = nloc; b.st[1] = nx; }
        const unsigned old = xb_add(&bar[XB_XSUB(b.x)], 1u);
        const unsigned gen = old / nloc;
        if (old + 1u == (gen + 1u) * nloc) {
            __builtin_amdgcn_fence(__ATOMIC_RELEASE, "agent");
            asm volatile("s_waitcnt vmcnt(0)" ::: "memory");
            const unsigned og = xb_add(&bar[XB_TOP], 1u);
            const unsigned tg = og / nx;
            if (og + 1u == (tg + 1u) * nx) xb_add(&bar[XB_TOPGEN], 1u);
            else XB_SPIN(xb_ld(&bar[XB_TOPGEN]) == tg, bar);
            __builtin_amdgcn_fence(__ATOMIC_ACQUIRE, "agent");
            xb_add(&bar[XB_XGEN(b.x)], 1u);
            asm volatile("s_waitcnt vmcnt(0)" ::: "memory");
        } else {
            XB_SPIN(xb_ld(&bar[XB_XGEN(b.x)]) == gen, bar);
            __builtin_amdgcn_fence(__ATOMIC_ACQUIRE, "agent");
            asm volatile("s_waitcnt vmcnt(0)" ::: "memory");
        }
    }
    __syncthreads();
}

DI void convert_pair(const Params& p, int wsel, int pair, float* ldsf_all) {
  const float* src1 = nullptr; const float* src2 = nullptr; const float* kscale = nullptr; bf16_t* dst = nullptr;
  int K = 0, ld = 0, nvalid = 0, kind = 0;
  switch (wsel) {
    case 0: src1 = p.f1w1; src2 = p.f1w3; dst = p.W13a; K = 1024; ld = DFF; nvalid = 5632; kind = 1; break;
    case 1: src1 = p.f1w2; dst = p.W2a; K = DFF; ld = 1024; nvalid = 1024; break;
    case 2: src1 = p.w_in; dst = p.Win; K = 1024; ld = NPROJ; nvalid = NPROJ; break;
    case 3: src1 = p.w_uq; dst = p.Wuq; K = 768; ld = 768; nvalid = 768; kscale = p.g_q; break;
    case 4: src1 = p.w_ukv; dst = p.Wukv; K = 256; ld = 1024; nvalid = 1024; kscale = p.g_kv; break;
    case 5: src1 = p.w_o_na; dst = p.Wona; K = 512; ld = 1024; nvalid = 1024; break;
    case 6: src1 = p.w_o_mla; dst = p.Womla; K = 512; ld = 1024; nvalid = 1024; break;
    case 7: src1 = p.w_out; dst = p.Wout; K = 1024; ld = 1024; nvalid = 1024; break;
    case 8: src1 = p.f2w1; src2 = p.f2w3; dst = p.W13b; K = 1024; ld = DFF; nvalid = 5632; kind = 1; break;
    default: src1 = p.f2w2; dst = p.W2b; K = DFF; ld = 1024; nvalid = 1024; break;
  }
  const int t512 = ltid(); const int half = t512 >> 8, tid = t512 & 255, lane = tid & 63, w = tid >> 6;
  float* ldsf = ldsf_all + half * (64 * 65);
  const int tile = pair * 2 + half;
  const int nkt = K >> 6;
  const int kt = tile % nkt, nt = tile / nkt;
  {
    const int n = nt * 64 + lane;
    const float* s = src1; int col = n; const bool valid = n < nvalid;
    if (kind == 1) {
      const int pn = n >> 8, bj = (n >> 7) & 1, cc = n & 127;
      col = 128 * pn + cc;
      s = bj ? src2 : src1;
    }
    float tv[16];
#pragma unroll
    for (int kk = 0; kk < 16; ++kk) {
      const int k = kt * 64 + w * 16 + kk;
      tv[kk] = valid ? s[(size_t)k * ld + col] : 0.f;
    }
#pragma unroll
    for (int kk = 0; kk < 16; ++kk) {
      const int kl = w * 16 + kk, k = kt * 64 + kl;
      float v = tv[kk];
      if (kscale) v *= kscale[k];
      ldsf[kl * 65 + lane] = v;
    }
  }
  __syncthreads();
  {
    const int r = tid >> 2, kq = (tid & 3) * 16;
    u32x4 o0, o1;
    float v[16];
#pragma unroll
    for (int i = 0; i < 16; ++i) v[i] = ldsf[(kq + i) * 65 + r];
    o0.x = pk_bf16(v[0], v[1]); o0.y = pk_bf16(v[2], v[3]); o0.z = pk_bf16(v[4], v[5]); o0.w = pk_bf16(v[6], v[7]);
    o1.x = pk_bf16(v[8], v[9]); o1.y = pk_bf16(v[10], v[11]); o1.z = pk_bf16(v[12], v[13]); o1.w = pk_bf16(v[14], v[15]);
    bf16_t* d = dst + (size_t)(nt * 64 + r) * K + kt * 64 + kq;
    *(u32x4*)d = o0; *(u32x4*)(d + 8) = o1;
  }
  __syncthreads();
}

DI void adaln_unit(const Params& p, int u, float* ldsf) {
  const int tid = ltid(), lane = tid & 63, kg = tid >> 6;
  {
    float cv[34];
#pragma unroll
    for (int i = 0; i < 34; ++i) {
      const int idx = tid + NT * i, r = idx >> 10, k = idx & 1023;
      cv[i] = (r < 16) ? p.c[r * 1024 + k] : p.c_ctx[k];
    }
#pragma unroll
    for (int i = 0; i < 34; ++i) ldsf[tid + NT * i] = cv[i] * __builtin_amdgcn_rcpf(1.f + __builtin_amdgcn_exp2f(-LOG2E * cv[i]));
  }
  __syncthreads();
  const int col = u * 64 + lane;
  float acc[17];
#pragma unroll
  for (int r = 0; r < 17; ++r) acc[r] = 0.f;
  const float* wp = p.w_ada + (size_t)(kg * 128) * 9216 + col;
  const float* sp = ldsf + kg * 128;
#pragma unroll 1
  for (int k0 = 0; k0 < 128; k0 += 16) {
    float wv[16];
#pragma unroll
    for (int kk = 0; kk < 16; ++kk) wv[kk] = wp[(size_t)(k0 + kk) * 9216];
#pragma unroll
    for (int kk = 0; kk < 16; ++kk)
#pragma unroll
      for (int r = 0; r < 17; ++r) acc[r] += sp[r * 1024 + k0 + kk] * wv[kk];
  }
  __syncthreads();
#pragma unroll
  for (int r = 0; r < 17; ++r) ldsf[(kg * 17 + r) * 64 + lane] = acc[r];
  __syncthreads();
  for (int idx = tid; idx < 17 * 64; idx += NT) {
    const int r = idx >> 6, cl = idx & 63;
    float s = 0.f;
#pragma unroll
    for (int g = 0; g < 8; ++g) s += ldsf[(g * 17 + r) * 64 + cl];
    p.mod[r * 9216 + u * 64 + cl] = s + p.b_ada[u * 64 + cl];
  }
  __syncthreads();
}

DI void phase0(const Params& p, float* ldsf) {
  const int G = gridDim.x, bid = blockIdx.x, tid = ltid();
  for (int i = bid * NT + tid; i < 5 * TA; i += G * NT) p.ssq[i] = 0.f;
  if (bid == G - 1) {
    for (int idx = tid; idx < 512; idx += NT) {
      const int pos = idx >> 3, i = idx & 7;
      float freq;
      switch (i) { case 0: freq = 1.0f; break; case 1: freq = 0.31622776601683794f; break; case 2: freq = 0.1f; break; case 3: freq = 0.031622776601683794f; break;
                   case 4: freq = 0.01f; break; case 5: freq = 0.0031622776601683794f; break; case 6: freq = 0.001f; break; default: freq = 0.00031622776601683794f; break; }
      const float angf = (float)pos * freq;
      const double a = (double)angf;
      const double n = __builtin_rint(a * 0.6366197723675814);
      const double rr = (a - n * 1.5707963267948966) - n * 6.123233995736766e-17;
      const int qd = ((int)n) & 3;
      const double r2 = rr * rr;
      const double sr = rr * (1.0 + r2 * (-1.0 / 6 + r2 * (1.0 / 120 + r2 * (-1.0 / 5040 + r2 * (1.0 / 362880 + r2 * (-1.0 / 39916800 + r2 * (1.0 / 6227020800.0)))))));
      const double cr = 1.0 + r2 * (-0.5 + r2 * (1.0 / 24 + r2 * (-1.0 / 720 + r2 * (1.0 / 40320 + r2 * (-1.0 / 3628800 + r2 * (1.0 / 479001600.0 + r2 * (-1.0 / 87178291200.0)))))));
      double sn, cs;
      if (qd == 0) { sn = sr; cs = cr; } else if (qd == 1) { sn = cr; cs = -sr; } else if (qd == 2) { sn = -sr; cs = -cr; } else { sn = -cr; cs = sr; }
      p.ropecs[idx] = (float)cs;
      p.ropecs[512 + idx] = (float)sn;
    }
  }
  constexpr int NT0 = 16 * 88 / 2;
  constexpr int NADA = 144;
  constexpr int TOTAL = NADA + NT0;
  if (G == 256) {
    if (bid < NADA) { adaln_unit(p, bid, ldsf); convert_pair(p, 0, bid, ldsf); }
    else { for (int i = 0; i < 5; ++i) convert_pair(p, 0, NADA + (bid - NADA) * 5 + i, ldsf); }
  } else {
    for (int u = bid; u < TOTAL; u += G) {
      if (u < NADA) { adaln_unit(p, u, ldsf); continue; }
      convert_pair(p, 0, u - NADA, ldsf);
    }
  }
}

DI void convert_w2a(const Params& p, float* ldsf, int first) {
  const int n = gridDim.x - first, me = blockIdx.x - first;
  if (me < 0) return;
  constexpr int NT1 = 44 * 16 / 2, NT2 = 16 * 76 / 2, NT3 = 12 * 12 / 2, NT4 = 4 * 16 / 2, NT5 = 8 * 16 / 2, NT6 = 8 * 16 / 2, NT7 = 16 * 16 / 2;
  constexpr int TOTAL = NT1 + NT2 + NT3 + NT4 + NT5;
  for (int u = me; u < TOTAL; u += n) {
    int t = u;
    if (t < NT1) { convert_pair(p, 1, t, ldsf); continue; } t -= NT1;
    if (t < NT2) { convert_pair(p, 2, t, ldsf); continue; } t -= NT2;
    if (t < NT3) { convert_pair(p, 3, t, ldsf); continue; } t -= NT3;
    if (t < NT4) { convert_pair(p, 4, t, ldsf); continue; } t -= NT4;
    convert_pair(p, 5, t, ldsf);
  }
}
DI void convert_rest(const Params& p, float* ldsf, int first) {
  const int n = gridDim.x - first, me = blockIdx.x - first;
  if (me < 0) return;
  constexpr int NT0 = 16 * 88 / 2, NT1 = 44 * 16 / 2, NT6 = 8 * 16 / 2, NT7 = 16 * 16 / 2;
  for (int u = me; u < NT0 + NT1 + NT6 + NT7; u += n) {
    if (u < NT0) convert_pair(p, 8, u, ldsf);
    else if (u < NT0 + NT1) convert_pair(p, 9, u - NT0, ldsf);
    else if (u < NT0 + NT1 + NT6) convert_pair(p, 6, u - NT0 - NT1, ldsf);
    else convert_pair(p, 7, u - NT0 - NT1 - NT6, ldsf);
  }
}

template <int PASS>
DI void row_pass(const Params& p) {
  const int t512 = ltid(); const int lane = t512 & 63, wid = t512 >> 6;
  const int nrows = (PASS <= 2) ? TA : TL;
  const int gwave = blockIdx.x * NW + wid, nwaves = gridDim.x * NW;
  const int per = (nrows + nwaves - 1) / nwaves;
  const int rbeg = gwave * per, rend = min(rbeg + per, nrows);
  const float* ng = p.norm_g;
  const bf16_t* Y = p.big + ((PASS == 3) ? OFF_Y2 : OFF_Y);
  const float* ssq = p.ssq + ((PASS == 2) ? 0 : (PASS == 3) ? 3 * TA : 4 * TA);
  f32x4 cres[4], cmul[4], cadd[4];
  f32x4 xn[4]; u32x2 xbn[4]; u32x2 yn[4]; float sn = 0.f;
  int curb = -1;
  auto load_vecs = [&](int b) {
    curb = b;
      const float* mod = p.mod + (size_t)b * 9216;
#pragma unroll
      for (int i = 0; i < 4; ++i) {
        const int col = (i * 64 + lane) * 4;
        if (PASS >= 2) {
          const float* gpost = ng + ((PASS == 2) ? 1 : (PASS == 3) ? 3 : 5) * 1024;
          const float* gate = mod + ((PASS == 2) ? 2 : (PASS == 3) ? 5 : 8) * 1024;
          const float wgt = (PASS == 3) ? 1.0f : 0.5f;
          cres[i] = wgt * (*(const f32x4*)(gate + col)) * (*(const f32x4*)(gpost + col));
        }
        if (PASS <= 3) {
          const float* gpre = ng + ((PASS == 1) ? 0 : (PASS == 2) ? 2 : 4) * 1024;
          const float* shift = mod + ((PASS == 1) ? 0 : (PASS == 2) ? 3 : 6) * 1024;
          const float* scale = mod + ((PASS == 1) ? 1 : (PASS == 2) ? 4 : 7) * 1024;
          cmul[i] = (*(const f32x4*)(gpre + col)) * (1.f + *(const f32x4*)(scale + col));
          cadd[i] = *(const f32x4*)(shift + col);
        }
      }
  };
  const int rend_main = (PASS == 2) ? min(rend, TL) : rend;
  for (int row = rbeg; row < rend_main; ++row) {
    const int b = (row < TL) ? (row >> 11) : 16;
    if (b != curb) load_vecs(b);
    auto xload = [&](int r, f32x4 (&xf)[4], u32x2 (&xb)[4]) {
      if (PASS <= 2) {
        const float* s = (r < TL) ? p.x + (size_t)r * 1024 : p.ctx + (size_t)(r - TL) * 1024;
#pragma unroll
        for (int i = 0; i < 4; ++i) xf[i] = *(const f32x4*)(s + (i * 64 + lane) * 4);
      } else {
        const bf16_t* s = (const bf16_t*)(p.out + (size_t)r * 1024);
#pragma unroll
        for (int i = 0; i < 4; ++i) xb[i] = *(const u32x2*)(s + (i * 64 + lane) * 4);
      }
    };
    f32x4 xv[4]; u32x2 xbv[4]; u32x2 yw[4]; float sq = 0.f;
    if (row == rbeg) {
      xload(row, xv, xbv);
      if (PASS >= 2) {
        sq = ssq[row];
#pragma unroll
        for (int i = 0; i < 4; ++i) yw[i] = *(const u32x2*)(Y + (size_t)row * 1024 + (i * 64 + lane) * 4);
      }
    } else {
#pragma unroll
      for (int i = 0; i < 4; ++i) { xv[i] = xn[i]; xbv[i] = xbn[i]; yw[i] = yn[i]; }
      sq = sn;
    }
    if (row + 1 < rend_main) {
      const int nr = row + 1;
      xload(nr, xn, xbn);
      if (PASS >= 2) {
        sn = ssq[nr];
#pragma unroll
        for (int i = 0; i < 4; ++i) yn[i] = *(const u32x2*)(Y + (size_t)nr * 1024 + (i * 64 + lane) * 4);
      }
    }
    if (PASS >= 3) {
#pragma unroll
      for (int i = 0; i < 4; ++i) {
        const u32x2 w = xbv[i];
        xv[i] = (f32x4){__uint_as_float(w.x << 16), __uint_as_float(w.x & 0xffff0000u), __uint_as_float(w.y << 16), __uint_as_float(w.y & 0xffff0000u)};
      }
    }
    if (PASS >= 2) {
      const float rs = rsqrtf(sq * (1.f / 1024.f) + RMS_EPS);
#pragma unroll
      for (int i = 0; i < 4; ++i) {
        const int col = (i * 64 + lane) * 4;
        const u32x2 w = yw[i];
        const f32x4 yv = {__uint_as_float(w.x << 16), __uint_as_float(w.x & 0xffff0000u), __uint_as_float(w.y << 16), __uint_as_float(w.y & 0xffff0000u)};
        xv[i] = xv[i] + (yv * rs) * cres[i];
        if (PASS == 4) *(f32x4*)(p.out + (size_t)row * 1024 + col) = xv[i];
        else if (row < TL) store_bf16x4((bf16_t*)(p.out + (size_t)row * 1024) + col, xv[i]);
      }
    }
    if (PASS <= 3) {
      float s = 0.f;
#pragma unroll
      for (int i = 0; i < 4; ++i) s += xv[i][0] * xv[i][0] + xv[i][1] * xv[i][1] + xv[i][2] * xv[i][2] + xv[i][3] * xv[i][3];
      s = wave_sum(s);
      const float rs = rsqrtf(s * (1.f / 1024.f) + RMS_EPS);
#pragma unroll
      for (int i = 0; i < 4; ++i) {
        const int col = (i * 64 + lane) * 4;
        store_bf16x4(p.H + (size_t)row * 1024 + col, (xv[i] * rs) * cmul[i] + cadd[i]);
      }
    }
  }
  if (PASS == 2) {
    for (int row = max(rbeg, TL); row < rend; ++row) {
      if (curb != 16) load_vecs(16);
      const float* xs = p.ctx + (size_t)(row - TL) * 1024;
      const float* y0 = p.xc + (size_t)(row - TL) * 1024;
      const float* y1 = p.yc1 + (size_t)(row - TL) * 1024;
      f32x4 xv[4], yv[4];
#pragma unroll
      for (int i = 0; i < 4; ++i) {
        const int col = (i * 64 + lane) * 4;
        xv[i] = *(const f32x4*)(xs + col);
        yv[i] = *(const f32x4*)(y0 + col) + *(const f32x4*)(y1 + col);
      }
      float sy = 0.f;
#pragma unroll
      for (int i = 0; i < 4; ++i) sy += yv[i][0] * yv[i][0] + yv[i][1] * yv[i][1] + yv[i][2] * yv[i][2] + yv[i][3] * yv[i][3];
      sy = wave_sum(sy);
      const float rsy = rsqrtf(sy * (1.f / 1024.f) + RMS_EPS);
      float s = 0.f;
#pragma unroll
      for (int i = 0; i < 4; ++i) {
        xv[i] = xv[i] + (yv[i] * rsy) * cres[i];
        s += xv[i][0] * xv[i][0] + xv[i][1] * xv[i][1] + xv[i][2] * xv[i][2] + xv[i][3] * xv[i][3];
      }
      s = wave_sum(s);
      const float rs = rsqrtf(s * (1.f / 1024.f) + RMS_EPS);
#pragma unroll
      for (int i = 0; i < 4; ++i) {
        const int col = (i * 64 + lane) * 4;
        store_bf16x4(p.H + (size_t)row * 1024 + col, (xv[i] * rs) * cmul[i] + cadd[i]);
      }
    }
  }
}

DI void mla_unit(const Params& p, int unit, bf16_t* lds) {
  const int tid = ltid(), lane = tid & 63, wid = tid >> 6, fr = lane & 15, fq = lane >> 4;
  const int qb = unit & 7, h = (unit >> 3) & 7, b = unit >> 6;
  const bf16_t* QM = p.big + OFF_QM;
  const bf16_t* KV = p.H;
  const bf16_t* KR = p.big + OFF_KR;
  bf16_t* OM = p.big + OFF_OM;
  bf16_t* sK = lds;
  bf16_t* sV = lds + 2 * 64 * LDK;
  const int q0 = b * 2048 + qb * 256 + wid * 32;
  bf16x8 qf[2][3];
#pragma unroll
  for (int qt = 0; qt < 2; ++qt)
#pragma unroll
    for (int ks = 0; ks < 3; ++ks) qf[qt][ks] = *(const bf16x8*)(QM + (size_t)(q0 + qt * 16 + fr) * 768 + h * 96 + ks * 32 + fq * 8);

  const int kr0 = tid / 12, kc0 = tid - kr0 * 12;
  const int kr1 = (tid + 512) / 12, kc1 = (tid + 512) - kr1 * 12;
  const bool k2 = tid < 256;
  const int vrow = tid >> 3, vch = tid & 7;
  u32x4 rk0, rk1, rv;
  auto load_tile = [&](int kt) {
    const int kbase = kt * 64;
    const int rowbase = (kbase < 2048) ? (b * 2048 + kbase) : (TL + b * 256 + (kbase - 2048));
    {
      const size_t r = rowbase + kr0;
      rk0 = *(const u32x4*)((kc0 < 8) ? (KV + r * 1024 + h * 128 + kc0 * 8) : (KR + r * 32 + (kc0 - 8) * 8));
    }
    if (k2) {
      const size_t r = rowbase + kr1;
      rk1 = *(const u32x4*)((kc1 < 8) ? (KV + r * 1024 + h * 128 + kc1 * 8) : (KR + r * 32 + (kc1 - 8) * 8));
    }
    rv = *(const u32x4*)(KV + (size_t)(rowbase + vrow) * 1024 + h * 128 + 64 + vch * 8);
  };
  auto store_tile = [&](int buf) {
    *(u32x4*)(sK + buf * 64 * LDK + kr0 * LDK + kc0 * 8) = rk0;
    if (k2) *(u32x4*)(sK + buf * 64 * LDK + kr1 * LDK + kc1 * 8) = rk1;
    *(u32x4*)(sV + buf * 64 * LDV + vrow * LDV + vch * 8) = rv;
  };

  f32x4 o[4][2], lacc[2];
  float mref[2];
#pragma unroll
  for (int qt = 0; qt < 2; ++qt) {
    mref[qt] = 0.f; lacc[qt] = (f32x4){0.f, 0.f, 0.f, 0.f};
#pragma unroll
    for (int dt = 0; dt < 4; ++dt) o[dt][qt] = (f32x4){0.f, 0.f, 0.f, 0.f};
  }
  const bf16x8 ones = {(short)0x3F80, (short)0x3F80, (short)0x3F80, (short)0x3F80, (short)0x3F80, (short)0x3F80, (short)0x3F80, (short)0x3F80};
  load_tile(0);
  store_tile(0);
  __syncthreads();
  constexpr int NKT = 36;
  for (int kt = 0; kt < NKT; ++kt) {
    const int cur = kt & 1;
    const bool more = kt + 1 < NKT;
    if (more) load_tile(kt + 1);
    const bf16_t* cK = sK + cur * 64 * LDK;
    const bf16_t* cV = sV + cur * 64 * LDV;
    f32x4 s[4][2], sinit[2];
#pragma unroll
    for (int qt = 0; qt < 2; ++qt) { const float ni = -mref[qt]; sinit[qt] = (f32x4){ni, ni, ni, ni}; }
    bf16x8 kf[3][4];
#pragma unroll
    for (int ks = 0; ks < 3; ++ks)
#pragma unroll
      for (int t4 = 0; t4 < 4; ++t4) kf[ks][t4] = *(const bf16x8*)(cK + (t4 * 16 + fr) * LDK + ks * 32 + fq * 8);
#pragma unroll
    for (int ks = 0; ks < 3; ++ks)
#pragma unroll
      for (int t4 = 0; t4 < 4; ++t4)
#pragma unroll
        for (int qt = 0; qt < 2; ++qt) s[t4][qt] = mfma16(kf[ks][t4], qf[qt][ks], ks == 0 ? sinit[qt] : s[t4][qt]);
    s16x4 vlo[2][4], vhi[2][4];
#pragma unroll
    for (int s2 = 0; s2 < 2; ++s2)
#pragma unroll
      for (int dt = 0; dt < 4; ++dt) {
        const bf16_t* vp = cV + (s2 * 32 + 4 * fq + (fr >> 2)) * LDV + dt * 16 + 4 * (fr & 3);
        vlo[s2][dt] = tr_read(vp); vhi[s2][dt] = tr_read(vp + 16 * LDV);
      }
    __builtin_amdgcn_sched_barrier(0);
    float mx[2];
#pragma unroll
    for (int qt = 0; qt < 2; ++qt) {
      float v = fmaxf(fmaxf(s[0][qt][0], s[0][qt][1]), fmaxf(s[0][qt][2], s[0][qt][3]));
#pragma unroll
      for (int t4 = 1; t4 < 4; ++t4) v = fmaxf(v, fmaxf(fmaxf(s[t4][qt][0], s[t4][qt][1]), fmaxf(s[t4][qt][2], s[t4][qt][3])));
      v = fmaxf(v, __shfl_xor(v, 16)); v = fmaxf(v, __shfl_xor(v, 32));
      mx[qt] = v;
    }
    if (__any((kt == 0) || (mx[0] > 8.f) || (mx[1] > 8.f))) {
#pragma unroll
      for (int qt = 0; qt < 2; ++qt) {
        const float delta = (kt == 0) ? mx[qt] : fmaxf(mx[qt], 0.f);
        mref[qt] += delta;
        const float sc = __builtin_amdgcn_exp2f(-delta);
#pragma unroll
        for (int t4 = 0; t4 < 4; ++t4) s[t4][qt] = s[t4][qt] - delta;
#pragma unroll
        for (int dt = 0; dt < 4; ++dt) o[dt][qt] = o[dt][qt] * sc;
        lacc[qt] = lacc[qt] * sc;
      }
    }
    bf16x8 pf[2][2];
#pragma unroll
    for (int qt = 0; qt < 2; ++qt) {
#pragma unroll
      for (int t4 = 0; t4 < 4; ++t4)
#pragma unroll
        for (int j = 0; j < 4; ++j) s[t4][qt][j] = __builtin_amdgcn_exp2f(s[t4][qt][j]);
#pragma unroll
      for (int s2 = 0; s2 < 2; ++s2) {
        u32x4 w;
        w.x = pk_bf16(s[2 * s2][qt][0], s[2 * s2][qt][1]); w.y = pk_bf16(s[2 * s2][qt][2], s[2 * s2][qt][3]);
        w.z = pk_bf16(s[2 * s2 + 1][qt][0], s[2 * s2 + 1][qt][1]); w.w = pk_bf16(s[2 * s2 + 1][qt][2], s[2 * s2 + 1][qt][3]);
        pf[s2][qt] = __builtin_bit_cast(bf16x8, w);
      }
    }
#pragma unroll
    for (int s2 = 0; s2 < 2; ++s2) {
#pragma unroll
      for (int dt = 0; dt < 4; ++dt) {
        const bf16x8 vf = cat8(vlo[s2][dt], vhi[s2][dt]);
#pragma unroll
        for (int qt = 0; qt < 2; ++qt) o[dt][qt] = mfma16(vf, pf[s2][qt], o[dt][qt]);
      }
#pragma unroll
      for (int qt = 0; qt < 2; ++qt) lacc[qt] = mfma16(ones, pf[s2][qt], lacc[qt]);
    }
    if (more) store_tile(cur ^ 1);
    __syncthreads();
  }
#pragma unroll
  for (int qt = 0; qt < 2; ++qt) {
    const float inv = 1.f / lacc[qt][0];
#pragma unroll
    for (int dt = 0; dt < 4; ++dt) store_bf16x4(OM + (size_t)(q0 + qt * 16 + fr) * 512 + h * 64 + dt * 16 + 4 * fq, o[dt][qt] * inv);
  }
}

DI void na_unit(const Params& p, int unit, bf16_t* lds, float* srpb) {
  const int tid = ltid(), lane = tid & 63, wid = tid >> 6, j = wid & 3, fr = lane & 15, fq = lane >> 4;
  const int rp = unit & 15, h = (unit >> 4) & 7, b = unit >> 7;
  const int r = 2 * rp + (wid >> 2);
  const bf16_t* QA = p.big + OFF_QA;
  const bf16_t* KA = p.big + OFF_KA;
  const bf16_t* VA = p.big + OFF_VA;
  bf16_t* sVl = lds;
  bf16_t* sVc = lds + 576 * LDT;
  bf16_t* sKl = sVc;
  const int rs0 = min(max(2 * rp - 4, 0), 24);
  const int rs = min(max(r - 4, 0), 24);
  const int ks = min(max(16 * j - 8, 0), 32);
  bf16_t* sKc = lds + (256 + 576) * LDT;
#pragma unroll
  for (int i = 0; i < 4; ++i) {
    const int idx = tid + NT * i, row = idx >> 3, ch = idx & 7;
    *(u32x4*)(sVc + row * LDT + ch * 8) = *(const u32x4*)(VA + (size_t)(TL + b * 256 + row) * 512 + h * 64 + ch * 8);
    *(u32x4*)(sKc + row * LDT + ch * 8) = *(const u32x4*)(KA + (size_t)(TL + b * 256 + row) * 512 + h * 64 + ch * 8);
  }
  {
    u32x4 tv[9];
#pragma unroll
    for (int i = 0; i < 9; ++i) {
      const int idx = tid + NT * i, row = idx >> 3, ch = idx & 7;
      const size_t tok = (size_t)b * 2048 + (rs0 + (row >> 6)) * 64 + (row & 63);
      tv[i] = *(const u32x4*)(VA + tok * 512 + h * 64 + ch * 8);
    }
#pragma unroll
    for (int i = 0; i < 9; ++i) {
      const int idx = tid + NT * i, row = idx >> 3, ch = idx & 7;
      *(u32x4*)(sVl + row * LDT + ch * 8) = tv[i];
    }
  }
  u32x4 tk[9];
#pragma unroll
  for (int i = 0; i < 9; ++i) {
    const int idx = tid + NT * i, row = idx >> 3, ch = idx & 7;
    const size_t tok = (size_t)b * 2048 + (rs0 + (row >> 6)) * 64 + (row & 63);
    tk[i] = *(const u32x4*)(KA + tok * 512 + h * 64 + ch * 8);
  }
  if (tid < 465) srpb[tid] = p.rpb[h * 465 + tid] * LOG2E;
  const size_t qrow = (size_t)b * 2048 + r * 64 + 16 * j + fr;
  bf16x8 qf[2];
  qf[0] = *(const bf16x8*)(QA + qrow * 512 + h * 64 + fq * 8);
  qf[1] = *(const bf16x8*)(QA + qrow * 512 + h * 64 + 32 + fq * 8);
  f32x4 o[4], lacc = {0.f, 0.f, 0.f, 0.f};
#pragma unroll
  for (int dt = 0; dt < 4; ++dt) o[dt] = (f32x4){0.f, 0.f, 0.f, 0.f};
  float mref = 0.f;
  const int qc = 16 * j + fr;
  const int wst = min(max(qc - 8, 0), 48);
  const bf16x8 ones = {(short)0x3F80, (short)0x3F80, (short)0x3F80, (short)0x3F80, (short)0x3F80, (short)0x3F80, (short)0x3F80, (short)0x3F80};
  bf16x8 kf[4][2];
  auto load_k = [&](int ci) {
    if (ci < 4) {
#pragma unroll
      for (int t = 0; t < 4; ++t) {
        const bf16_t* kp = sKc + (ci * 64 + t * 16 + fr) * LDT + fq * 8;
        kf[t][0] = *(const bf16x8*)kp; kf[t][1] = *(const bf16x8*)(kp + 32);
      }
    } else {
      const int rbase = (rs - rs0 + 2 * (ci - 4)) * 64 + ks;
#pragma unroll
      for (int t = 0; t < 4; ++t) {
        const int rl = rbase + (t >> 1) * 64 + (t & 1) * 16 + fr;
        const bf16_t* kp = sKl + rl * 64;
        kf[t][0] = *(const bf16x8*)(kp + ((fq ^ (rl & 7)) * 8));
        kf[t][1] = *(const bf16x8*)(kp + (((4 + fq) ^ (rl & 7)) * 8));
      }
    }
  };
  int co8[2][4]; bool ok8[2][4];
#pragma unroll
  for (int e = 0; e < 2; ++e)
#pragma unroll
    for (int jj = 0; jj < 4; ++jj) {
      const int kc = ks + e * 16 + 4 * fq + jj;
      ok8[e][jj] = (kc >= wst) && (kc < wst + 16);
      co8[e][jj] = min(max(kc - qc, -15), 15) + 15;
    }
  __syncthreads();
  load_k(0);
#pragma unroll 1
  for (int ci = 0; ci < 8; ++ci) {
    const int half = ci >> 2, c = ci & 3;
    if (ci == 4) {
      __syncthreads();
#pragma unroll
      for (int i = 0; i < 9; ++i) {
        const int idx = tid + NT * i, row = idx >> 3, ch = idx & 7;
        *(u32x4*)(sKl + row * 64 + ((ch ^ (row & 7)) * 8)) = tk[i];
      }
      __syncthreads();
      load_k(4);
    }
    f32x4 s[4];
    const f32x4 sinit = {-mref, -mref, -mref, -mref};
#pragma unroll
    for (int t = 0; t < 4; ++t) {
      f32x4 a = mfma16(kf[t][0], qf[0], sinit);
      a = mfma16(kf[t][1], qf[1], a);
      s[t] = a;
    }
    if (ci < 7 && ci != 3) load_k(ci + 1);
    if (half == 1) {
      float bias[4][4];
#pragma unroll
      for (int t = 0; t < 4; ++t) {
        const int ro = (rs + 2 * c + (t >> 1) - r + 7) * 31;
#pragma unroll
        for (int jj = 0; jj < 4; ++jj) bias[t][jj] = srpb[ro + co8[t & 1][jj]];
      }
#pragma unroll
      for (int t = 0; t < 4; ++t)
#pragma unroll
        for (int jj = 0; jj < 4; ++jj) s[t][jj] = ok8[t & 1][jj] ? (s[t][jj] + bias[t][jj]) : -1e30f;
    }
    float mx = fmaxf(fmaxf(s[0][0], s[0][1]), fmaxf(s[0][2], s[0][3]));
#pragma unroll
    for (int t = 1; t < 4; ++t) mx = fmaxf(mx, fmaxf(fmaxf(s[t][0], s[t][1]), fmaxf(s[t][2], s[t][3])));
    mx = fmaxf(mx, __shfl_xor(mx, 16)); mx = fmaxf(mx, __shfl_xor(mx, 32));
    if (__any((ci == 0) || (mx > 8.f))) {
      const float delta = (ci == 0) ? mx : fmaxf(mx, 0.f);
      mref += delta;
      const float sc = __builtin_amdgcn_exp2f(-delta);
#pragma unroll
      for (int t = 0; t < 4; ++t) s[t] = s[t] - delta;
#pragma unroll
      for (int dt = 0; dt < 4; ++dt) o[dt] = o[dt] * sc;
      lacc = lacc * sc;
    }
#pragma unroll
    for (int s2 = 0; s2 < 2; ++s2) {
      f32x4 e0, e1;
#pragma unroll
      for (int jj = 0; jj < 4; ++jj) {
        e0[jj] = __builtin_amdgcn_exp2f(s[2 * s2][jj]);
        e1[jj] = __builtin_amdgcn_exp2f(s[2 * s2 + 1][jj]);
      }
      u32x4 w;
      w.x = pk_bf16(e0[0], e0[1]); w.y = pk_bf16(e0[2], e0[3]); w.z = pk_bf16(e1[0], e1[1]); w.w = pk_bf16(e1[2], e1[3]);
      const bf16x8 pf = __builtin_bit_cast(bf16x8, w);
      const bf16_t* vb = (half == 0) ? (sVc + (c * 64 + s2 * 32) * LDT) : (sVl + ((rs - rs0 + 2 * c + s2) * 64 + ks) * LDT);
#pragma unroll
      for (int dt = 0; dt < 4; ++dt) {
        const bf16_t* vp = vb + (4 * fq + (fr >> 2)) * LDT + dt * 16 + 4 * (fr & 3);
        const bf16x8 vf = cat8(tr_read(vp), tr_read(vp + 16 * LDT));
        o[dt] = mfma16(vf, pf, o[dt]);
      }
      lacc = mfma16(ones, pf, lacc);
    }
  }
  const float inv = 1.f / lacc[0];
#pragma unroll
  for (int dt = 0; dt < 4; ++dt) store_bf16x4(p.big + OFF_ON + qrow * 512 + h * 64 + dt * 16 + 4 * fq, o[dt] * inv);
  __syncthreads();
}

__global__ void __launch_bounds__(512) fwd_megakernel(Params p) {
  cg::grid_group grid = cg::this_grid();
  __shared__ __attribute__((aligned(16))) unsigned char lds_raw[LDS_BYTES];
  __shared__ float srpb[480];
  bf16_t* lds = (bf16_t*)lds_raw;
  float* ldsf = (float*)lds_raw;
  PG8_LAS unsigned char* glds = (PG8_LAS unsigned char*)lds_raw;
  const int G = gridDim.x, bid = blockIdx.x;
  using namespace pg8;
  __shared__ __attribute__((aligned(16))) unsigned xb_st[4];
  if (threadIdx.x < 4) xb_st[threadIdx.x] = 0u;
  __syncthreads();
  const XcdBarrier xb = xcd_barrier_post(p.bar, (volatile LAS unsigned*)xb_st);

  phase0(p, ldsf);
  if (p.never) grid.sync();
  xcd_barrier(xb);
  row_pass<1>(p);
  xcd_barrier(xb);
  { SubOrder S; S.init(TA / 256, 22, 0, 0, WGM_UP); gemm_phase(glds, Gemm{p.H, p.W13a, TA, 5632, 1024}, S, EpiSwiglu{p.big + OFF_U}); }
  { const int r = (TA / 256 * 22) % G; convert_w2a(p, ldsf, r); }
  xcd_barrier(xb);
  { SubOrder S; S.init(TL / 256, 4, 0, 0, WGM_N4); gemm_phase(glds, Gemm{p.big + OFF_U, p.W2a, TL, 1024, DFF}, S, EpiStoreSsq{p.big + OFF_Y, p.ssq + 0 * TA}); }
  { ShiftOrder S{TL / 256, 0, 64}; gemm_phase(glds, Gemm{p.big + OFF_U, p.W2a, TA, 1024, DFF / 2, DFF, DFF}, S, EpiStoreF32{p.xc, TL}); }
  { ShiftOrder S{TL / 256, 64, 64}; gemm_phase(glds, Gemm{p.big + OFF_U + DFF / 2, p.W2a + DFF / 2, TA, 1024, DFF / 2, DFF, DFF}, S, EpiStoreF32{p.yc1, TL}); }
  convert_rest(p, ldsf, 128 < G ? 128 : 0);
  xcd_barrier(xb);
  row_pass<2>(p);
  xcd_barrier(xb);
  { ProjOrder S; S.init(); gemm_phase(glds, Gemm{p.H, p.Win, TA, NPROJP, 1024}, S, EpiProj{p.big, p.b_gate, p.ropecs, p.ssq + 1 * TA, p.ssq + 2 * TA}); }
  xcd_barrier(xb);
  { SubOrder S; S.init(TL / 256, 3, 0, 0, WGM_N4); gemm_phase(glds, Gemm{p.big + OFF_CQ, p.Wuq, TL, 768, 768}, S, EpiQup{p.big + OFF_QM, p.ssq + 1 * TA, p.ropecs}); }
  { KvOrder S; gemm_phase(glds, Gemm{p.big + OFF_CKV, p.Wukv, TA, 1024, 256}, S, EpiKVup{p.H, p.ssq + 2 * TA}); }
  xcd_barrier(xb);
  {
    const int xcd = bid & 7, loc = bid >> 3, per = G >> 3;
    for (int i = 0; (i * 8 + xcd) * per + loc < 1024; ++i) mla_unit(p, (i * 8 + xcd) * per + loc, lds);
    for (int i = 0; (i * 8 + xcd) * per + loc < 2048; ++i) na_unit(p, (i * 8 + xcd) * per + loc, lds, srpb);
  }
  xcd_barrier(xb);
  { SubOrder S; S.init(TL / 256, 4, 0, 0, WGM_N4); gemm_phase(glds, Gemm{p.big + OFF_ON, p.Wona, TL, 1024, 512}, S, EpiGate<false>{p.H, p.big + OFF_G, 0}); }
  { SubOrder S; S.init(TL / 256, 4, 0, 0, WGM_N4); gemm_phase(glds, Gemm{p.big + OFF_OM, p.Womla, TL, 1024, 512}, S, EpiGate<true>{p.H, p.big + OFF_G, 1024}); }
  xcd_barrier(xb);
  { SubOrder S; S.init(TL / 256, 4, 0, 0, WGM_N4); gemm_phase(glds, Gemm{p.H, p.Wout, TL, 1024, 1024}, S, EpiStoreSsq{p.big + OFF_Y2, p.ssq + 3 * TA}); }
  xcd_barrier(xb);
  row_pass<3>(p);
  xcd_barrier(xb);
  { SubOrder S; S.init(TL / 256, 22, 0, 0, WGM_UP); gemm_phase(glds, Gemm{p.H, p.W13b, TL, 5632, 1024}, S, EpiSwiglu{p.big + OFF_U}); }
  xcd_barrier(xb);
  { SubOrder S; S.init(TL / 256, 4, 0, 0, WGM_N4); gemm_phase(glds, Gemm{p.big + OFF_U, p.W2b, TL, 1024, DFF}, S, EpiStoreSsq{p.big + OFF_Y, p.ssq + 4 * TA}); }
  xcd_barrier(xb);
  row_pass<4>(p);
}

extern "C" void kernel_launch(void* const* d_in, const int* in_sizes, int n_in, void* d_out, int out_size, void* d_ws, size_t ws_size,
                              hipStream_t stream) {
  static int grid_blocks = 0;
  if (!grid_blocks) {
    int dev = 0, cus = 0, per_cu = 0;
    (void)hipGetDevice(&dev);
    (void)hipDeviceGetAttribute(&cus, hipDeviceAttributeMultiprocessorCount, dev);
    (void)hipOccupancyMaxActiveBlocksPerMultiprocessor(&per_cu, fwd_megakernel, NT, 0);
    if (per_cu > 1) per_cu = 1;
    grid_blocks = (cus * per_cu) & ~7;
  }
  Params p{};
  const float* const* in = (const float* const*)d_in;
  p.x = in[0]; p.c = in[1]; p.ctx = in[2]; p.c_ctx = in[3]; p.w_ada = in[4]; p.b_ada = in[5]; p.norm_g = in[6];
  p.f1w1 = in[7]; p.f1w3 = in[8]; p.f1w2 = in[9]; p.w_in = in[10]; p.b_gate = in[11]; p.g_q = in[12]; p.g_kv = in[13];
  p.w_uq = in[14]; p.w_ukv = in[15]; p.rpb = in[16]; p.w_o_na = in[17]; p.w_o_mla = in[18]; p.w_out = in[19];
  p.f2w1 = in[20]; p.f2w3 = in[21]; p.f2w2 = in[22];
  p.out = (float*)d_out;
  unsigned char* ws = (unsigned char*)d_ws;
  size_t off = 0;
  auto take = [&](size_t bytes) { size_t o = off; off += (bytes + 255) & ~(size_t)255; return ws + o; };
  p.bar = (unsigned*)take((size_t)XCD_BAR_WORDS * 4);
  p.mod = (float*)take((size_t)17 * 9216 * 4);
  p.ropecs = (float*)take(1024 * 4);
  p.ssq = (float*)take((size_t)5 * TA * 4);
  p.W13a = (bf16_t*)take((size_t)5632 * 1024 * 2);
  p.W2a = (bf16_t*)take((size_t)1024 * DFF * 2);
  p.Win = (bf16_t*)take((size_t)NPROJP * 1024 * 2);
  p.Wuq = (bf16_t*)take((size_t)768 * 768 * 2);
  p.Wukv = (bf16_t*)take((size_t)1024 * 256 * 2);
  p.Wona = (bf16_t*)take((size_t)1024 * 512 * 2);
  p.Womla = (bf16_t*)take((size_t)1024 * 512 * 2);
  p.Wout = (bf16_t*)take((size_t)1024 * 1024 * 2);
  p.W13b = (bf16_t*)take((size_t)5632 * 1024 * 2);
  p.W2b = (bf16_t*)take((size_t)1024 * DFF * 2);
  p.xc = (float*)take((size_t)TC * 1024 * 4);
  p.yc1 = (float*)take((size_t)TC * 1024 * 4);
  p.H = (bf16_t*)take((size_t)TA * 1024 * 2);
  p.big = (bf16_t*)take(BIG_ELEMS * 2);
  if (off > ws_size) { fprintf(stderr, "workspace too small: need %zu have %zu\n", off, ws_size); return; }
  (void)hipMemsetAsync(p.bar, 0, (size_t)XCD_BAR_WORDS * 4, stream);
  void* args[] = {&p};
  hipError_t e = hipLaunchCooperativeKernel((void*)fwd_megakernel, dim3(grid_blocks), dim3(NT), args, 0, stream);
  if (e != hipSuccess) fprintf(stderr, "cooperative launch failed: %s (grid %d)\n", hipGetErrorString(e), grid_blocks);
}
```

```cpp
#include <hip/hip_runtime.h>
#include <hip/hip_cooperative_groups.h>
#include <cstdint>
#include <cstdio>
namespace cg = cooperative_groups;

typedef unsigned short bf16_t;
typedef short bf16x8 __attribute__((ext_vector_type(8)));
typedef short s16x4 __attribute__((ext_vector_type(4)));
typedef float f32x4 __attribute__((ext_vector_type(4)));
typedef float f32x2 __attribute__((ext_vector_type(2)));
typedef unsigned u32x4 __attribute__((ext_vector_type(4)));
typedef unsigned u32x2 __attribute__((ext_vector_type(2)));
typedef __bf16 bf2_t __attribute__((ext_vector_type(2)));

#define DI __device__ __forceinline__

constexpr int NT = 512;
constexpr int NW = 8;
constexpr int TL = 32768;
constexpr int TC = 4096;
constexpr int TA = 36864;
constexpr int DFF = 2816;
constexpr int NPROJ = 4640;
constexpr int NPROJP = 4864;
constexpr int LDT = 72;
constexpr int LDV = 80;
constexpr int LDK = 104;
constexpr int LDS_BYTES = (256 + 576 + 256) * LDT * 2;
static_assert(LDS_BYTES >= 131072, "GEMM stage ring");
constexpr float RMS_EPS = 1e-6f;
constexpr float LOG2E = 1.4426950408889634f;

struct Params {
  const float *x, *c, *ctx, *c_ctx, *w_ada, *b_ada, *norm_g, *f1w1, *f1w3, *f1w2, *w_in, *b_gate, *g_q, *g_kv,
      *w_uq, *w_ukv, *rpb, *w_o_na, *w_o_mla, *w_out, *f2w1, *f2w3, *f2w2;
  float* out;
  long never;
  unsigned* bar;
  float* mod;
  float* ropecs;
  float* ssq;
  bf16_t *W13a, *W2a, *Win, *Wuq, *Wukv, *Wona, *Womla, *Wout, *W13b, *W2b;
  float* xc;
  float* yc1;
  bf16_t* H;
  bf16_t* big;
};

constexpr size_t OFF_U = 0;
constexpr size_t OFF_Y = (size_t)TA * DFF;
constexpr size_t OFF_QA = 0;
constexpr size_t OFF_KA = OFF_QA + (size_t)TL * 512;
constexpr size_t OFF_VA = OFF_KA + (size_t)TA * 512;
constexpr size_t OFF_CQ = OFF_VA + (size_t)TA * 512;
constexpr size_t OFF_CKV = OFF_CQ + (size_t)TL * 768;
constexpr size_t OFF_KR = OFF_CKV + (size_t)TA * 256;
constexpr size_t OFF_G = OFF_KR + (size_t)TA * 32;
constexpr size_t OFF_QM = OFF_G + (size_t)TL * 2048;
constexpr size_t BIG_ELEMS = OFF_QM + (size_t)TL * 768;
constexpr size_t OFF_OM = OFF_CQ;
constexpr size_t OFF_ON = OFF_OM + (size_t)TL * 512;
static_assert(OFF_ON + (size_t)TL * 512 <= OFF_KR, "NA output must fit before KR");
constexpr size_t OFF_Y2 = OFF_KA;

DI int ltid() { int t = threadIdx.x; asm volatile("" : "+v"(t)); return t; }
DI unsigned pk_bf16(float lo, float hi) {
  f32x2 v = {lo, hi};
  bf2_t r = __builtin_convertvector(v, bf2_t);
  return __builtin_bit_cast(unsigned, r);
}
DI void store_bf16x4(bf16_t* p, f32x4 v) {
  u32x2 w; w.x = pk_bf16(v[0], v[1]); w.y = pk_bf16(v[2], v[3]);
  *(u32x2*)p = w;
}
DI f32x4 load_bf16x4(const bf16_t* p) {
  const u32x2 w = *(const u32x2*)p;
  return (f32x4){__uint_as_float(w.x << 16), __uint_as_float(w.x & 0xffff0000u), __uint_as_float(w.y << 16), __uint_as_float(w.y & 0xffff0000u)};
}
DI f32x4 mfma16(bf16x8 a, bf16x8 b, f32x4 c) { return __builtin_amdgcn_mfma_f32_16x16x32_bf16(a, b, c, 0, 0, 0); }
DI s16x4 tr_read(const bf16_t* p) {
  return __builtin_amdgcn_ds_read_tr16_b64_v4i16((__attribute__((address_space(3))) s16x4*)p);
}
DI bf16x8 cat8(s16x4 lo, s16x4 hi) { return __builtin_shufflevector(lo, hi, 0, 1, 2, 3, 4, 5, 6, 7); }
DI float wave_sum(float v) {
  v += __shfl_xor(v, 32); v += __shfl_xor(v, 16); v += __shfl_xor(v, 8);
  v += __shfl_xor(v, 4); v += __shfl_xor(v, 2); v += __shfl_xor(v, 1);
  return v;
}

DI f32x4 rope4(f32x4 v, int fq, int pos, const float* ropecs) {
  f32x4 o;
#pragma unroll
  for (int j = 0; j < 4; ++j) {
    const float other = __shfl_xor(v[j], 32);
    const int i = (4 * fq + j) & 7;
    const float cs = ropecs[pos * 8 + i], sn = ropecs[512 + pos * 8 + i];
    o[j] = (fq < 2) ? (v[j] * cs - other * sn) : (v[j] * cs + other * sn);
  }
  return o;
}

DI f32x4 rope4p(f32x4 v, int n, int fq, int pos_row, int pos_col, const float* ropecs) {
  const int pos = (fq >> 1) ? pos_col : pos_row;
  f32x4 o;
#pragma unroll
  for (int j = 0; j < 4; ++j) {
    const float other = __shfl_xor(v[j], 16);
    const int i = 4 * n + j;
    const float cs = ropecs[pos * 8 + i], sn = ropecs[512 + pos * 8 + i];
    o[j] = ((fq & 1) == 0) ? (v[j] * cs - other * sn) : (v[j] * cs + other * sn);
  }
  return o;
}
DI void store_bf16x8(bf16_t* p, f32x4 a, f32x4 b) {
  u32x4 w; w.x = pk_bf16(a[0], a[1]); w.y = pk_bf16(a[2], a[3]); w.z = pk_bf16(b[0], b[1]); w.w = pk_bf16(b[2], b[3]);
  *(u32x4*)p = w;
}
DI void load_bf16x8(const bf16_t* p, f32x4& a, f32x4& b) {
  const u32x4 w = *(const u32x4*)p;
  a = (f32x4){__uint_as_float(w.x << 16), __uint_as_float(w.x & 0xffff0000u), __uint_as_float(w.y << 16), __uint_as_float(w.y & 0xffff0000u)};
  b = (f32x4){__uint_as_float(w.z << 16), __uint_as_float(w.z & 0xffff0000u), __uint_as_float(w.w << 16), __uint_as_float(w.w & 0xffff0000u)};
}

#ifndef WGM_UP
#define WGM_UP 2
#endif
#ifndef WGM_N4
#define WGM_N4 4
#endif
#ifndef WGM_PROJ
#define WGM_PROJ 3
#endif
namespace pg8 {
#define PG8_LAS __attribute__((address_space(3)))
constexpr int BM = 256, BK = 64, HALF = 128, HTB = HALF * BK * 2, STAGE_BYTES = 8 * HTB, NXCD = 8, WGM = 4;
__host__ __device__ __forceinline__ int lds_byte(int r, int c) { const int st = (r >> 4) * 2 + (c >> 5), rr = r & 15, cc = c & 31, ob = rr * 64 + cc * 2; return st * 1024 + (ob ^ (((ob >> 9) & 1) << 5)); }
__host__ __device__ __forceinline__ void stage_rc(int b, int& R, int& C) { const int st = b / 1024, sb = b % 1024, swz = sb ^ (((sb >> 9) & 1) << 5); R = (st >> 1) * 16 + swz / 64; C = (st & 1) * 32 + (swz % 64) / 2; }
__host__ __device__ __forceinline__ int perm32(int rho) { const int n = rho >> 4, i = rho & 15; return 8 * (i >> 2) + 4 * n + (i & 3); }

struct Unit { int pm, pn; };
struct Gemm { const bf16_t* A; const bf16_t* Bt; int M, N, K; int lda = 0, ldb = 0; };

struct StaticOrder {
    int nM, nN, nwg, G, c, wgm = WGM;
    __host__ __device__ void init(int M, int N, int G_, int c_) { nM = M / BM; nN = N / BM; nwg = nM * nN; G = G_; c = c_; }
    __host__ __device__ bool next(int i, Unit& u) const {
        const long L = (long)i * G + c; if (L >= nwg) return false;
        int wgid = (int)L; { const int q = nwg / NXCD, r = nwg % NXCD, xcd = wgid % NXCD, off = wgid / NXCD; wgid = (xcd < r ? xcd * (q + 1) : r * (q + 1) + (xcd - r) * q) + off; }
        const int nig = wgm * nN, gid = wgid / nig, fm = gid * wgm, gsz = (nM - fm) < wgm ? (nM - fm) : wgm;
        u.pm = fm + ((wgid % nig) % gsz); u.pn = (wgid % nig) / gsz; return true;
    }
    __device__ __forceinline__ void a_ready(const Unit&) const {}
    __device__ __forceinline__ void done(const Unit&) const {}
};
template <class Epi, class Sched, bool ALIGN_EPI = true, bool SP2 = true>
__device__ __forceinline__ void gemm_phase(PG8_LAS unsigned char* lds, const Gemm g, const Sched& S, const Epi& E) {
    int tid = threadIdx.x; asm volatile("" : "+v"(tid));
    const int wid = __builtin_amdgcn_readfirstlane(tid >> 6), lane = tid & 63, wr = wid >> 2, wc = wid & 3, fr = lane & 15, fq = lane >> 4;
    int K = g.K; asm volatile("" : "+s"(K)); const int nt = K / BK;
    int lda = g.lda ? g.lda : g.K, ldb = g.ldb ? g.ldb : g.K; asm volatile("" : "+s"(lda), "+s"(ldb));
    unsigned voffA[2], voffB[2];
#pragma unroll
    for (int i = 0; i < 2; ++i) { int R, C; stage_rc(tid * 16 + i * 8192, R, C); const int Rb = Epi::PERM ? ((R & ~31) + perm32(R & 31)) : R;
        voffA[i] = (unsigned)(R * lda + C) * 2u; voffB[i] = (unsigned)(Rb * ldb + C) * 2u; }
    const size_t kstep = (size_t)(BK * 2);
    const size_t hstepA = (size_t)HALF * lda * 2, hstepB = (size_t)HALF * ldb * 2;
    const size_t tstepA = 2 * hstepA, tstepB = 2 * hstepB;
    const unsigned ldsw = (unsigned)wid * 1024u;
    const int aoff = lds_byte(wr * 64 + fr, fq * 8), boff = lds_byte(wc * 32 + fr, fq * 8);
#define PG8_SA(b, h) (((b) * 2 + (h)) * HTB)
#define PG8_SB(b, h) ((4 + (b) * 2 + (h)) * HTB)
#define PG8_STAGE(bufoff, gbase, voff) do { _Pragma("unroll") for (int _i = 0; _i < 2; ++_i) \
        __builtin_amdgcn_global_load_lds((const unsigned*)((const char*)(gbase) + (voff)[_i]), (PG8_LAS unsigned*)(lds + (bufoff) + ldsw + _i * 8192), 16, 0, 0); } while (0)
#define PG8_LDA(dst, b, h) do { _Pragma("unroll") for (int m = 0; m < 4; ++m) _Pragma("unroll") for (int k = 0; k < 2; ++k) dst[m][k] = *(const PG8_LAS bf16x8*)(lds + PG8_SA(b, h) + aoff + m * 2048 + k * 1024); } while (0)
#define PG8_LDB(dst, b, h) do { _Pragma("unroll") for (int n = 0; n < 2; ++n) _Pragma("unroll") for (int k = 0; k < 2; ++k) dst[n][k] = *(const PG8_LAS bf16x8*)(lds + PG8_SB(b, h) + boff + n * 2048 + k * 1024); } while (0)
#define PG8_MMA(ai, bj, At, Bt) do { __builtin_amdgcn_s_setprio(1); _Pragma("unroll") for (int m = 0; m < 4; ++m) _Pragma("unroll") for (int n = 0; n < 2; ++n) _Pragma("unroll") for (int k = 0; k < 2; ++k) \
        acc[ai][bj][m][n] = __builtin_amdgcn_mfma_f32_16x16x32_bf16(Bt[n][k], At[m][k], acc[ai][bj][m][n], 0, 0, 0); __builtin_amdgcn_s_setprio(0); } while (0)
#define PG8_WAIT_V(n) asm volatile("s_waitcnt vmcnt(" #n ")" ::: "memory")
#define PG8_WAIT_L(n) asm volatile("s_waitcnt lgkmcnt(" #n ")" ::: "memory")
#define PG8_BAR __builtin_amdgcn_s_barrier()
#define PG8_SCHED __builtin_amdgcn_sched_barrier(0)
    Unit cur, nxt; int ui = 0;
    if (!S.next(0, cur)) return;
    f32x4 acc[2][2][4][2];
#pragma unroll
    for (int a = 0; a < 2; ++a)
#pragma unroll
        for (int b = 0; b < 2; ++b)
#pragma unroll
            for (int m = 0; m < 4; ++m)
#pragma unroll
                for (int n = 0; n < 2; ++n) acc[a][b][m][n] = (f32x4){0.f, 0.f, 0.f, 0.f};
    bf16x8 At[4][2], B0[2][2], B1[2][2];
    const char* cA = (const char*)g.A + (size_t)cur.pm * tstepA; const char* cB = (const char*)g.Bt + (size_t)cur.pn * tstepB;
    S.a_ready(cur);
    if constexpr (SP2) {
        PG8_STAGE(PG8_SB(0, 0), cB, voffB); PG8_STAGE(PG8_SB(0, 1), cB + hstepB, voffB); PG8_STAGE(PG8_SA(0, 0), cA, voffA); PG8_STAGE(PG8_SA(0, 1), cA + hstepA, voffA);
        if (wr == 1) PG8_BAR;
        PG8_WAIT_V(2); PG8_BAR;
        PG8_STAGE(PG8_SB(1, 0), cB + kstep, voffB); PG8_STAGE(PG8_SA(1, 0), cA + kstep, voffA); PG8_STAGE(PG8_SB(1, 1), cB + hstepB + kstep, voffB);
        PG8_WAIT_V(6); PG8_BAR;
    } else {
        PG8_STAGE(PG8_SB(0, 0), cB, voffB); PG8_STAGE(PG8_SA(0, 0), cA, voffA); PG8_STAGE(PG8_SB(0, 1), cB + hstepB, voffB); PG8_STAGE(PG8_SA(0, 1), cA + hstepA, voffA);
        if (wr == 1) PG8_BAR;
        PG8_WAIT_V(4); PG8_BAR;
        PG8_STAGE(PG8_SB(1, 0), cB + kstep, voffB); PG8_STAGE(PG8_SA(1, 0), cA + kstep, voffA); PG8_STAGE(PG8_SB(1, 1), cB + hstepB + kstep, voffB);
        PG8_WAIT_V(6); PG8_BAR;
    }
    for (;;) {
        const bool has_next = S.next(ui + 1, nxt);
        const char* nA = has_next ? (const char*)g.A + (size_t)nxt.pm * tstepA : cA; const char* nB = has_next ? (const char*)g.Bt + (size_t)nxt.pn * tstepB : cB;
        for (int t = 0; t < nt; t += 2) {
            const bool last = (t == nt - 2);
            const char* a1 = cA + (size_t)(t + 1) * kstep;
            const char* a2 = last ? nA : cA + (size_t)(t + 2) * kstep; const char* b2 = last ? nB : cB + (size_t)(t + 2) * kstep;
            const char* a3 = a2 + kstep; const char* b3 = b2 + kstep;
            if (last && has_next) S.a_ready(nxt);
            if constexpr (SP2) {
            PG8_LDB(B0, 0, 0); PG8_LDB(B1, 0, 1); PG8_SCHED; PG8_LDA(At, 0, 0); PG8_STAGE(PG8_SA(1, 1), a1 + hstepA, voffA);
            PG8_WAIT_V(8); PG8_WAIT_L(0); PG8_BAR; PG8_MMA(0, 0, At, B0); PG8_MMA(0, 1, At, B1); PG8_BAR; PG8_SCHED;
            PG8_LDA(At, 0, 1); PG8_STAGE(PG8_SB(0, 0), b2, voffB); PG8_STAGE(PG8_SB(0, 1), b2 + hstepB, voffB); PG8_STAGE(PG8_SA(0, 0), a2, voffA);
            PG8_WAIT_V(8); PG8_WAIT_L(0); PG8_BAR; PG8_MMA(1, 0, At, B0); PG8_MMA(1, 1, At, B1); PG8_BAR; PG8_SCHED;
            PG8_LDB(B0, 1, 0); PG8_LDB(B1, 1, 1); PG8_SCHED; PG8_LDA(At, 1, 0); PG8_STAGE(PG8_SA(0, 1), a2 + hstepA, voffA);
            PG8_WAIT_V(8); PG8_WAIT_L(0); PG8_BAR; PG8_MMA(0, 0, At, B0); PG8_MMA(0, 1, At, B1); PG8_BAR; PG8_SCHED;
            PG8_LDA(At, 1, 1); PG8_STAGE(PG8_SB(1, 0), b3, voffB); PG8_STAGE(PG8_SB(1, 1), b3 + hstepB, voffB); PG8_STAGE(PG8_SA(1, 0), a3, voffA);
            PG8_WAIT_V(8); PG8_WAIT_L(0); PG8_BAR; PG8_MMA(1, 0, At, B0); PG8_MMA(1, 1, At, B1); PG8_BAR; PG8_SCHED;
            } else {
            PG8_LDB(B0, 0, 0); PG8_SCHED; PG8_LDA(At, 0, 0); PG8_STAGE(PG8_SA(1, 1), a1 + hstepA, voffA);
            PG8_WAIT_L(8); PG8_BAR; PG8_WAIT_L(0); PG8_MMA(0, 0, At, B0); PG8_BAR; PG8_SCHED;
            PG8_LDB(B1, 0, 1); PG8_STAGE(PG8_SB(0, 0), b2, voffB);
            PG8_BAR; PG8_WAIT_L(0); PG8_MMA(0, 1, At, B1); PG8_BAR;
            PG8_LDA(At, 0, 1); PG8_STAGE(PG8_SA(0, 0), a2, voffA);
            PG8_BAR; PG8_WAIT_L(0); PG8_MMA(1, 0, At, B0); PG8_BAR; PG8_SCHED;
            PG8_STAGE(PG8_SB(0, 1), b2 + hstepB, voffB);
            PG8_WAIT_V(6); PG8_BAR; PG8_MMA(1, 1, At, B1); PG8_BAR;
            PG8_LDB(B0, 1, 0); PG8_SCHED; PG8_LDA(At, 1, 0); PG8_STAGE(PG8_SA(0, 1), a2 + hstepA, voffA);
            PG8_WAIT_L(8); PG8_BAR; PG8_WAIT_L(0); PG8_MMA(0, 0, At, B0); PG8_BAR; PG8_SCHED;
            PG8_LDB(B1, 1, 1); PG8_STAGE(PG8_SB(1, 0), b3, voffB);
            PG8_BAR; PG8_WAIT_L(0); PG8_MMA(0, 1, At, B1); PG8_BAR;
            PG8_LDA(At, 1, 1); PG8_STAGE(PG8_SA(1, 0), a3, voffA);
            PG8_BAR; PG8_WAIT_L(0); PG8_MMA(1, 0, At, B0); PG8_BAR; PG8_SCHED;
            PG8_STAGE(PG8_SB(1, 1), b3 + hstepB, voffB);
            PG8_WAIT_V(6); PG8_BAR; PG8_MMA(1, 1, At, B1); PG8_BAR;
            }
        }
        if constexpr (ALIGN_EPI) { if (wr == 0) PG8_BAR; }
        if constexpr (!Epi::AFTER_DRAIN) { E(acc, cur, wr, wc, fr, fq); S.done(cur); }
        if (!has_next) break;
#pragma unroll
        for (int a = 0; a < 2; ++a)
#pragma unroll
            for (int b = 0; b < 2; ++b)
#pragma unroll
                for (int m = 0; m < 4; ++m)
#pragma unroll
                    for (int n = 0; n < 2; ++n) acc[a][b][m][n] = (f32x4){0.f, 0.f, 0.f, 0.f};
        cur = nxt; cA = nA; cB = nB; ++ui;
        if constexpr (ALIGN_EPI) { if (wr == 1) PG8_BAR; }
    }
    PG8_WAIT_V(0);
    if constexpr (!ALIGN_EPI) { if (wr == 0) PG8_BAR; }
    PG8_BAR;
    if constexpr (Epi::AFTER_DRAIN) { E.fused(acc, cur, wr, wc, fr, fq, lds, wid, lane); S.done(cur); }
#undef PG8_SA
#undef PG8_SB
#undef PG8_STAGE
#undef PG8_LDA
#undef PG8_LDB
#undef PG8_MMA
#undef PG8_WAIT_V
#undef PG8_WAIT_L
#undef PG8_BAR
#undef PG8_SCHED
}
struct SubOrder {
  StaticOrder so; int pm0, pn0;
  __device__ void init(int nM, int nN, int pm0_, int pn0_, int wgm_ = WGM) { so.init(nM * BM, nN * BM, gridDim.x, blockIdx.x); so.wgm = wgm_; pm0 = pm0_; pn0 = pn0_; }
  __device__ bool next(int i, Unit& u) const { if (!so.next(i, u)) return false; u.pm += pm0; u.pn += pn0; return true; }
  __device__ __forceinline__ void a_ready(const Unit&) const {}
  __device__ __forceinline__ void done(const Unit&) const {}
};
struct ProjOrder {
  StaticOrder so; int G, c;
  __device__ void init() { G = gridDim.x; c = blockIdx.x; so.init(TL, NPROJP, G, c); so.wgm = WGM_PROJ; }
  __device__ bool next(int i, Unit& u) const {
    const long L = (long)i * G + c;
    if (L < 128 * 19) return so.next(i, u);
    const int idx = (int)L - 128 * 19;
    if (idx >= 96) return false;
    const int k = idx % 6;
    u.pm = 128 + idx / 6; u.pn = (k < 4) ? (2 + k) : (5 + k);
    return true;
  }
  __device__ __forceinline__ void a_ready(const Unit&) const {}
  __device__ __forceinline__ void done(const Unit&) const {}
};

struct ShiftOrder {
  int pm0, c0, n;
  __device__ bool next(int i, Unit& u) const {
    const int idx = (int)blockIdx.x - c0;
    if (i > 0 || idx < 0 || idx >= n) return false;
    u.pm = pm0 + (idx >> 2); u.pn = idx & 3;
    return true;
  }
  __device__ __forceinline__ void a_ready(const Unit&) const {}
  __device__ __forceinline__ void done(const Unit&) const {}
};
struct KvOrder {
  __device__ bool next(int i, Unit& u) const {
    const int c = blockIdx.x;
    int idx;
    if (gridDim.x != 256) { idx = i * (int)gridDim.x + c; if (idx >= 576) return false; }
    else if (c >= 128) { if (i >= 4) return false; idx = (c - 128) * 4 + i; }
    else if (c < 64) { if (i >= 1) return false; idx = 512 + c; }
    else return false;
    u.pm = idx >> 2; u.pn = idx & 3;
    return true;
  }
  __device__ __forceinline__ void a_ready(const Unit&) const {}
  __device__ __forceinline__ void done(const Unit&) const {}
};
struct EpiStoreF32 {
  static constexpr bool PERM = true, AFTER_DRAIN = false;
  float* Yp; int row0;
  __device__ __forceinline__ void operator()(const f32x4 (&acc)[2][2][4][2], const Unit& u, int wr, int wc, int fr, int fq) const {
    asm volatile("" : "+v"(fr), "+v"(fq));
#pragma unroll
    for (int ai = 0; ai < 2; ++ai)
#pragma unroll
      for (int m = 0; m < 4; ++m) {
        const size_t row = (size_t)u.pm * BM + ai * HALF + wr * 64 + m * 16 + fr - row0;
#pragma unroll
        for (int bj = 0; bj < 2; ++bj) {
          float* d = Yp + row * 1024 + u.pn * BM + bj * HALF + wc * 32 + 8 * fq;
          *(f32x4*)d = acc[ai][bj][m][0]; *(f32x4*)(d + 4) = acc[ai][bj][m][1];
        }
      }
  }
};

struct EpiSwiglu {
  static constexpr bool PERM = true, AFTER_DRAIN = false;
  bf16_t* U;
  __device__ __forceinline__ void operator()(const f32x4 (&acc)[2][2][4][2], const Unit& u, int wr, int wc, int fr, int fq) const {
    asm volatile("" : "+v"(fr), "+v"(fq));
#pragma unroll
    for (int ai = 0; ai < 2; ++ai)
#pragma unroll
      for (int m = 0; m < 4; ++m) {
        const size_t row = (size_t)u.pm * BM + ai * HALF + wr * 64 + m * 16 + fr;
        f32x4 v[2];
#pragma unroll
        for (int n = 0; n < 2; ++n) {
          const f32x4 a = acc[ai][0][m][n], b = acc[ai][1][m][n];
#pragma unroll
          for (int j = 0; j < 4; ++j) v[n][j] = a[j] * __builtin_amdgcn_rcpf(1.f + __builtin_amdgcn_exp2f(-LOG2E * a[j])) * b[j];
        }
        u32x4 w; w.x = pk_bf16(v[0][0], v[0][1]); w.y = pk_bf16(v[0][2], v[0][3]); w.z = pk_bf16(v[1][0], v[1][1]); w.w = pk_bf16(v[1][2], v[1][3]);
        *(u32x4*)(U + row * DFF + u.pn * 128 + wc * 32 + 8 * fq) = w;
      }
  }
};

struct EpiStoreSsq {
  static constexpr bool PERM = true, AFTER_DRAIN = false;
  bf16_t* Y; float* ssq;
  __device__ __forceinline__ void operator()(const f32x4 (&acc)[2][2][4][2], const Unit& u, int wr, int wc, int fr, int fq) const {
    asm volatile("" : "+v"(fr), "+v"(fq));
#pragma unroll
    for (int ai = 0; ai < 2; ++ai)
#pragma unroll
      for (int m = 0; m < 4; ++m) {
        const size_t row = (size_t)u.pm * BM + ai * HALF + wr * 64 + m * 16 + fr;
        float s = 0.f;
#pragma unroll
        for (int bj = 0; bj < 2; ++bj) {
          const f32x4 v0 = acc[ai][bj][m][0], v1 = acc[ai][bj][m][1];
          s += v0[0] * v0[0] + v0[1] * v0[1] + v0[2] * v0[2] + v0[3] * v0[3] + v1[0] * v1[0] + v1[1] * v1[1] + v1[2] * v1[2] + v1[3] * v1[3];
          u32x4 w; w.x = pk_bf16(v0[0], v0[1]); w.y = pk_bf16(v0[2], v0[3]); w.z = pk_bf16(v1[0], v1[1]); w.w = pk_bf16(v1[2], v1[3]);
          *(u32x4*)(Y + row * 1024 + u.pn * BM + bj * HALF + wc * 32 + 8 * fq) = w;
        }
        s += __shfl_xor(s, 16); s += __shfl_xor(s, 32);
        if (fq == 0) atomicAdd(ssq + row, s);
      }
  }
};

struct EpiProj {
  static constexpr bool PERM = true, AFTER_DRAIN = false;
  bf16_t* big; const float* b_gate; const float* ropecs; float* ssq_q; float* ssq_kv;
  __device__ __forceinline__ void operator()(const f32x4 (&acc)[2][2][4][2], const Unit& u, int wr, int wc, int fr, int fq) const {
    asm volatile("" : "+v"(fr), "+v"(fq));
    const int pn = u.pn;
    const bool latent = u.pm < 128;
    if (pn < 6) {
      bf16_t* dst = big + ((pn < 2) ? OFF_QA : (pn < 4) ? OFF_KA : OFF_VA);
      const float sc = (pn < 2) ? 0.125f * LOG2E : 1.f;
      const int c0 = (pn & 1) * 256;
#pragma unroll
      for (int ai = 0; ai < 2; ++ai)
#pragma unroll
        for (int m = 0; m < 4; ++m) {
          const size_t row = (size_t)u.pm * BM + ai * HALF + wr * 64 + m * 16 + fr;
#pragma unroll
          for (int bj = 0; bj < 2; ++bj) store_bf16x8(dst + row * 512 + c0 + bj * HALF + wc * 32 + 8 * fq, acc[ai][bj][m][0] * sc, acc[ai][bj][m][1] * sc);
          asm volatile("" ::: "memory");
        }
    } else if (pn < 10) {
      const bool isq = pn < 9;
      bf16_t* dst = big + (isq ? OFF_CQ : OFF_CKV);
      const int ld = isq ? 768 : 256, c0 = isq ? (pn - 6) * 256 : 0;
      float* ssq = isq ? ssq_q : ssq_kv;
#pragma unroll
      for (int ai = 0; ai < 2; ++ai)
#pragma unroll
        for (int m = 0; m < 4; ++m) {
          const size_t row = (size_t)u.pm * BM + ai * HALF + wr * 64 + m * 16 + fr;
          float s = 0.f;
#pragma unroll
          for (int bj = 0; bj < 2; ++bj) {
            const f32x4 v0 = acc[ai][bj][m][0], v1 = acc[ai][bj][m][1];
            s += v0[0] * v0[0] + v0[1] * v0[1] + v0[2] * v0[2] + v0[3] * v0[3] + v1[0] * v1[0] + v1[1] * v1[1] + v1[2] * v1[2] + v1[3] * v1[3];
            store_bf16x8(dst + row * ld + c0 + bj * HALF + wc * 32 + 8 * fq, v0, v1);
          }
          s += __shfl_xor(s, 16); s += __shfl_xor(s, 32);
          if (fq == 0) atomicAdd(ssq + row, s);
          asm volatile("" ::: "memory");
        }
    } else {
#pragma unroll
      for (int bj = 0; bj < 2; ++bj) {
        const int colg = pn * BM + bj * HALF + wc * 32;
        if (colg == 2560) {
#pragma unroll
          for (int ai = 0; ai < 2; ++ai)
#pragma unroll
            for (int m = 0; m < 4; ++m) {
              const int row = u.pm * BM + ai * HALF + wr * 64 + m * 16 + fr;
              f32x4 v0 = acc[ai][bj][m][0], v1 = acc[ai][bj][m][1];
              if (latent) {
                const int t = row & 2047;
                v0 = rope4p(v0, 0, fq, t >> 6, t & 63, ropecs);
                v1 = rope4p(v1, 1, fq, t >> 6, t & 63, ropecs);
              }
              store_bf16x8(big + OFF_KR + (size_t)row * 32 + 8 * fq, v0, v1);
              asm volatile("" ::: "memory");
            }
        } else if (colg < NPROJ && latent) {
          const int gc = colg - 2592 + 8 * fq;
          const f32x4 bg0 = *(const f32x4*)(b_gate + gc), bg1 = *(const f32x4*)(b_gate + gc + 4);
#pragma unroll
          for (int ai = 0; ai < 2; ++ai)
#pragma unroll
            for (int m = 0; m < 4; ++m) {
              const int row = u.pm * BM + ai * HALF + wr * 64 + m * 16 + fr;
              f32x4 v0 = acc[ai][bj][m][0] + bg0, v1 = acc[ai][bj][m][1] + bg1;
#pragma unroll
              for (int j = 0; j < 4; ++j) {
                v0[j] = __builtin_amdgcn_rcpf(1.f + __builtin_amdgcn_exp2f(-LOG2E * v0[j]));
                v1[j] = __builtin_amdgcn_rcpf(1.f + __builtin_amdgcn_exp2f(-LOG2E * v1[j]));
              }
              store_bf16x8(big + OFF_G + (size_t)row * 2048 + gc, v0, v1);
              asm volatile("" ::: "memory");
            }
        }
      }
    }
  }
};

struct EpiQup {
  static constexpr bool PERM = true, AFTER_DRAIN = false;
  bf16_t* QM; const float* ssq_q; const float* ropecs;
  __device__ __forceinline__ void operator()(const f32x4 (&acc)[2][2][4][2], const Unit& u, int wr, int wc, int fr, int fq) const {
    asm volatile("" : "+v"(fr), "+v"(fq));
#pragma unroll
    for (int ai = 0; ai < 2; ++ai)
#pragma unroll
      for (int m = 0; m < 4; ++m) {
        const int row = u.pm * BM + ai * HALF + wr * 64 + m * 16 + fr;
        const float rs = rsqrtf(ssq_q[row] * (1.f / 768.f) + RMS_EPS) * (0.10206207261596575f * LOG2E);
        const int t = row & 2047;
#pragma unroll
        for (int bj = 0; bj < 2; ++bj) {
          const int colg = u.pn * BM + bj * HALF + wc * 32;
          f32x4 v0 = acc[ai][bj][m][0] * rs, v1 = acc[ai][bj][m][1] * rs;
          if (colg % 96 == 64) {
            v0 = rope4p(v0, 0, fq, t >> 6, t & 63, ropecs);
            v1 = rope4p(v1, 1, fq, t >> 6, t & 63, ropecs);
          }
          store_bf16x8(QM + (size_t)row * 768 + colg + 8 * fq, v0, v1);
        }
      }
  }
};

struct EpiKVup {
  static constexpr bool PERM = true, AFTER_DRAIN = false;
  bf16_t* KV; const float* ssq_kv;
  __device__ __forceinline__ void operator()(const f32x4 (&acc)[2][2][4][2], const Unit& u, int wr, int wc, int fr, int fq) const {
    asm volatile("" : "+v"(fr), "+v"(fq));
#pragma unroll
    for (int ai = 0; ai < 2; ++ai)
#pragma unroll
      for (int m = 0; m < 4; ++m) {
        const int row = u.pm * BM + ai * HALF + wr * 64 + m * 16 + fr;
        const float rs = rsqrtf(ssq_kv[row] * (1.f / 256.f) + RMS_EPS);
#pragma unroll
        for (int bj = 0; bj < 2; ++bj) store_bf16x8(KV + (size_t)row * 1024 + u.pn * BM + bj * HALF + wc * 32 + 8 * fq, acc[ai][bj][m][0] * rs, acc[ai][bj][m][1] * rs);
      }
  }
};

template <bool ADD>
struct EpiGate {
  static constexpr bool PERM = true, AFTER_DRAIN = false;
  bf16_t* Y1; const bf16_t* G; int gcol0;
  __device__ __forceinline__ void operator()(const f32x4 (&acc)[2][2][4][2], const Unit& u, int wr, int wc, int fr, int fq) const {
    asm volatile("" : "+v"(fr), "+v"(fq));
#pragma unroll
    for (int ai = 0; ai < 2; ++ai)
#pragma unroll
      for (int m = 0; m < 4; ++m) {
        const size_t row = (size_t)u.pm * BM + ai * HALF + wr * 64 + m * 16 + fr;
#pragma unroll
        for (int bj = 0; bj < 2; ++bj) {
          const int col = u.pn * BM + bj * HALF + wc * 32 + 8 * fq;
          f32x4 g0, g1; load_bf16x8(G + row * 2048 + gcol0 + col, g0, g1);
          f32x4 v0 = acc[ai][bj][m][0] * g0, v1 = acc[ai][bj][m][1] * g1;
          if (ADD) { f32x4 y0, y1; load_bf16x8(Y1 + row * 1024 + col, y0, y1); v0 = v0 + y0; v1 = v1 + y1; }
          store_bf16x8(Y1 + row * 1024 + col, v0, v1);
        }
      }
  }
};
}

#define LAS __attribute__((address_space(3)))
#define XB_TMO      128
#define XB_XCNT(j)  (256  + 64 * (j))
#define XB_XSUB(j)  (1280 + 64 * (j))
#define XB_XGEN(j)  (2304 + 64 * (j))
#define XB_TOP      3328
#define XB_TOPGEN   3392
#define XCD_BAR_WORDS 3456
#define XB_SPIN_CAP (1u << 18)

__device__ __forceinline__ unsigned xb_ld(unsigned* p)              { return __hip_atomic_load(p, __ATOMIC_RELAXED, __HIP_MEMORY_SCOPE_AGENT); }
__device__ __forceinline__ unsigned xb_add(unsigned* p, unsigned v) { return __hip_atomic_fetch_add(p, v, __ATOMIC_RELAXED, __HIP_MEMORY_SCOPE_AGENT); }
__device__ __forceinline__ unsigned xb_xcc_id() { return (unsigned)__builtin_amdgcn_s_getreg((3 << 11) | 20) & 0xFu; }
#define XB_SPIN(cond, bar) do { unsigned _sp = 0; while (cond) { __builtin_amdgcn_s_sleep(1); \
    if ((++_sp & 255u) == 0u) { if (xb_ld(&(bar)[XB_TMO])) break; if (_sp > XB_SPIN_CAP) { atomicAdd(&(bar)[XB_TMO], 1u); break; } } } } while (0)

struct XcdBarrier {
    unsigned* bar; unsigned x;
    volatile LAS unsigned* st;
};

__device__ __forceinline__ XcdBarrier xcd_barrier_post(unsigned* bar, volatile LAS unsigned* st) {
    XcdBarrier b; b.bar = bar; b.x = xb_xcc_id(); b.st = st;
    if (threadIdx.x == 0) (void)xb_add(&bar[XB_XCNT(b.x)], 1u);
    return b;
}
__device__ __forceinline__ void xcd_barrier_complete(unsigned* bar, unsigned x, unsigned& nloc, unsigned& nx) {
    const unsigned G = gridDim.x * gridDim.y * gridDim.z;
    unsigned sum, cnt, mine, sp = 0u;
    for (;;) {
        sum = 0u; cnt = 0u; mine = 0u;
#pragma unroll
        for (unsigned j = 0; j < 16; ++j) { const unsigned c = xb_ld(&bar[XB_XCNT(j)]); sum += c; cnt += (c > 0u) ? 1u : 0u; mine = (j == x) ? c : mine; }
        if (sum == G) break;
        __builtin_amdgcn_s_sleep(1);
        if ((++sp & 255u) == 0u) { if (xb_ld(&bar[XB_TMO])) break; if (sp > XB_SPIN_CAP) { atomicAdd(&bar[XB_TMO], 1u); break; } }
    }
    nloc = mine > 0u ? mine : 1u; nx = cnt > 0u ? cnt : 1u;
}

__device__ __forceinline__ void xcd_barrier(const XcdBarrier& b) {
    asm volatile("s_waitcnt vmcnt(0)" ::: "memory");
    __syncthreads();
    if (threadIdx.x == 0) {
        unsigned* bar = b.bar;
        __builtin_amdgcn_s_waitcnt(0);
        unsigned nloc = b.st[0], nx = b.st[1];
        if (nloc == 0u) { xcd_barrier_complete(bar, b.x, nloc, nx); b.st[0] = nloc; b.st[1] = nx; }
        const unsigned old = xb_add(&bar[XB_XSUB(b.x)], 1u);
        const unsigned gen = old / nloc;
        if (old + 1u == (gen + 1u) * nloc) {
            __builtin_amdgcn_fence(__ATOMIC_RELEASE, "agent");
            asm volatile("s_waitcnt vmcnt(0)" ::: "memory");
            const unsigned og = xb_add(&bar[XB_TOP], 1u);
            const unsigned tg = og / nx;
            if (og + 1u == (tg + 1u) * nx) xb_add(&bar[XB_TOPGEN], 1u);
            else XB_SPIN(xb_ld(&bar[XB_TOPGEN]) == tg, bar);
            __builtin_amdgcn_fence(__ATOMIC_ACQUIRE, "agent");
            xb_add(&bar[XB_XGEN(b.x)], 1u);
            asm volatile("s_waitcnt vmcnt(0)" ::: "memory");
        } else {
            XB_SPIN(xb_ld(&bar[XB_XGEN(b.x)]) == gen, bar);
            __builtin_amdgcn_fence(__ATOMIC_ACQUIRE, "agent");
            asm volatile("s_waitcnt vmcnt(0)" ::: "memory");
        }
    }
    __syncthreads();
}

DI void convert_pair(const Params& p, int wsel, int pair, float* ldsf_all) {
  const float* src1 = nullptr; const float* src2 = nullptr; const float* kscale = nullptr; bf16_t* dst = nullptr;
  int K = 0, ld = 0, nvalid = 0, kind = 0;
  switch (wsel) {
    case 0: src1 = p.f1w1; src2 = p.f1w3; dst = p.W13a; K = 1024; ld = DFF; nvalid = 5632; kind = 1; break;
    case 1: src1 = p.f1w2; dst = p.W2a; K = DFF; ld = 1024; nvalid = 1024; break;
    case 2: src1 = p.w_in; dst = p.Win; K = 1024; ld = NPROJ; nvalid = NPROJ; break;
    case 3: src1 = p.w_uq; dst = p.Wuq; K = 768; ld = 768; nvalid = 768; kscale = p.g_q; break;
    case 4: src1 = p.w_ukv; dst = p.Wukv; K = 256; ld = 1024; nvalid = 1024; kscale = p.g_kv; break;
    case 5: src1 = p.w_o_na; dst = p.Wona; K = 512; ld = 1024; nvalid = 1024; break;
    case 6: src1 = p.w_o_mla; dst = p.Womla; K = 512; ld = 1024; nvalid = 1024; break;
    case 7: src1 = p.w_out; dst = p.Wout; K = 1024; ld = 1024; nvalid = 1024; break;
    case 8: src1 = p.f2w1; src2 = p.f2w3; dst = p.W13b; K = 1024; ld = DFF; nvalid = 5632; kind = 1; break;
    default: src1 = p.f2w2; dst = p.W2b; K = DFF; ld = 1024; nvalid = 1024; break;
  }
  const int t512 = ltid(); const int half = t512 >> 8, tid = t512 & 255, lane = tid & 63, w = tid >> 6;
  float* ldsf = ldsf_all + half * (64 * 65);
  const int tile = pair * 2 + half;
  const int nkt = K >> 6;
  const int kt = tile % nkt, nt = tile / nkt;
  {
    const int n = nt * 64 + lane;
    const float* s = src1; int col = n; const bool valid = n < nvalid;
    if (kind == 1) {
      const int pn = n >> 8, bj = (n >> 7) & 1, cc = n & 127;
      col = 128 * pn + cc;
      s = bj ? src2 : src1;
    }
    float tv[16];
#pragma unroll
    for (int kk = 0; kk < 16; ++kk) {
      const int k = kt * 64 + w * 16 + kk;
      tv[kk] = valid ? s[(size_t)k * ld + col] : 0.f;
    }
#pragma unroll
    for (int kk = 0; kk < 16; ++kk) {
      const int kl = w * 16 + kk, k = kt * 64 + kl;
      float v = tv[kk];
      if (kscale) v *= kscale[k];
      ldsf[kl * 65 + lane] = v;
    }
  }
  __syncthreads();
  {
    const int r = tid >> 2, kq = (tid & 3) * 16;
    u32x4 o0, o1;
    float v[16];
#pragma unroll
    for (int i = 0; i < 16; ++i) v[i] = ldsf[(kq + i) * 65 + r];
    o0.x = pk_bf16(v[0], v[1]); o0.y = pk_bf16(v[2], v[3]); o0.z = pk_bf16(v[4], v[5]); o0.w = pk_bf16(v[6], v[7]);
    o1.x = pk_bf16(v[8], v[9]); o1.y = pk_bf16(v[10], v[11]); o1.z = pk_bf16(v[12], v[13]); o1.w = pk_bf16(v[14], v[15]);
    bf16_t* d = dst + (size_t)(nt * 64 + r) * K + kt * 64 + kq;
    *(u32x4*)d = o0; *(u32x4*)(d + 8) = o1;
  }
  __syncthreads();
}

DI void adaln_unit(const Params& p, int u, float* ldsf) {
  const int tid = ltid(), lane = tid & 63, kg = tid >> 6;
  {
    float cv[34];
#pragma unroll
    for (int i = 0; i < 34; ++i) {
      const int idx = tid + NT * i, r = idx >> 10, k = idx & 1023;
      cv[i] = (r < 16) ? p.c[r * 1024 + k] : p.c_ctx[k];
    }
#pragma unroll
    for (int i = 0; i < 34; ++i) ldsf[tid + NT * i] = cv[i] * __builtin_amdgcn_rcpf(1.f + __builtin_amdgcn_exp2f(-LOG2E * cv[i]));
  }
  __syncthreads();
  const int col = u * 64 + lane;
  float acc[17];
#pragma unroll
  for (int r = 0; r < 17; ++r) acc[r] = 0.f;
  const float* wp = p.w_ada + (size_t)(kg * 128) * 9216 + col;
  const float* sp = ldsf + kg * 128;
#pragma unroll 1
  for (int k0 = 0; k0 < 128; k0 += 16) {
    float wv[16];
#pragma unroll
    for (int kk = 0; kk < 16; ++kk) wv[kk] = wp[(size_t)(k0 + kk) * 9216];
#pragma unroll
    for (int kk = 0; kk < 16; ++kk)
#pragma unroll
      for (int r = 0; r < 17; ++r) acc[r] += sp[r * 1024 + k0 + kk] * wv[kk];
  }
  __syncthreads();
#pragma unroll
  for (int r = 0; r < 17; ++r) ldsf[(kg * 17 + r) * 64 + lane] = acc[r];
  __syncthreads();
  for (int idx = tid; idx < 17 * 64; idx += NT) {
    const int r = idx >> 6, cl = idx & 63;
    float s = 0.f;
#pragma unroll
    for (int g = 0; g < 8; ++g) s += ldsf[(g * 17 + r) * 64 + cl];
    p.mod[r * 9216 + u * 64 + cl] = s + p.b_ada[u * 64 + cl];
  }
  __syncthreads();
}

DI void phase0(const Params& p, float* ldsf) {
  const int G = gridDim.x, bid = blockIdx.x, tid = ltid();
  for (int i = bid * NT + tid; i < 5 * TA; i += G * NT) p.ssq[i] = 0.f;
  if (bid == G - 1) {
    for (int idx = tid; idx < 512; idx += NT) {
      const int pos = idx >> 3, i = idx & 7;
      float freq;
      switch (i) { case 0: freq = 1.0f; break; case 1: freq = 0.31622776601683794f; break; case 2: freq = 0.1f; break; case 3: freq = 0.031622776601683794f; break;
                   case 4: freq = 0.01f; break; case 5: freq = 0.0031622776601683794f; break; case 6: freq = 0.001f; break; default: freq = 0.00031622776601683794f; break; }
      const float angf = (float)pos * freq;
      const double a = (double)angf;
      const double n = __builtin_rint(a * 0.6366197723675814);
      const double rr = (a - n * 1.5707963267948966) - n * 6.123233995736766e-17;
      const int qd = ((int)n) & 3;
      const double r2 = rr * rr;
      const double sr = rr * (1.0 + r2 * (-1.0 / 6 + r2 * (1.0 / 120 + r2 * (-1.0 / 5040 + r2 * (1.0 / 362880 + r2 * (-1.0 / 39916800 + r2 * (1.0 / 6227020800.0)))))));
      const double cr = 1.0 + r2 * (-0.5 + r2 * (1.0 / 24 + r2 * (-1.0 / 720 + r2 * (1.0 / 40320 + r2 * (-1.0 / 3628800 + r2 * (1.0 / 479001600.0 + r2 * (-1.0 / 87178291200.0)))))));
      double sn, cs;
      if (qd == 0) { sn = sr; cs = cr; } else if (qd == 1) { sn = cr; cs = -sr; } else if (qd == 2) { sn = -sr; cs = -cr; } else { sn = -cr; cs = sr; }
      p.ropecs[idx] = (float)cs;
      p.ropecs[512 + idx] = (float)sn;
    }
  }
  constexpr int NT0 = 16 * 88 / 2;
  constexpr int NADA = 144;
  constexpr int TOTAL = NADA + NT0;
  if (G == 256) {
    if (bid < NADA) { adaln_unit(p, bid, ldsf); convert_pair(p, 0, bid, ldsf); }
    else { for (int i = 0; i < 5; ++i) convert_pair(p, 0, NADA + (bid - NADA) * 5 + i, ldsf); }
  } else {
    for (int u = bid; u < TOTAL; u += G) {
      if (u < NADA) { adaln_unit(p, u, ldsf); continue; }
      convert_pair(p, 0, u - NADA, ldsf);
    }
  }
}

DI void convert_w2a(const Params& p, float* ldsf, int first) {
  const int n = gridDim.x - first, me = blockIdx.x - first;
  if (me < 0) return;
  constexpr int NT1 = 44 * 16 / 2, NT2 = 16 * 76 / 2, NT3 = 12 * 12 / 2, NT4 = 4 * 16 / 2, NT5 = 8 * 16 / 2, NT6 = 8 * 16 / 2, NT7 = 16 * 16 / 2;
  constexpr int TOTAL = NT1 + NT2 + NT3 + NT4 + NT5 + NT6 + NT7;
  for (int u = me; u < TOTAL; u += n) {
    int t = u;
    if (t < NT1) { convert_pair(p, 1, t, ldsf); continue; } t -= NT1;
    if (t < NT2) { convert_pair(p, 2, t, ldsf); continue; } t -= NT2;
    if (t < NT3) { convert_pair(p, 3, t, ldsf); continue; } t -= NT3;
    if (t < NT4) { convert_pair(p, 4, t, ldsf); continue; } t -= NT4;
    if (t < NT5) { convert_pair(p, 5, t, ldsf); continue; } t -= NT5;
    if (t < NT6) { convert_pair(p, 6, t, ldsf); continue; } t -= NT6;
    convert_pair(p, 7, t, ldsf);
  }
}
DI void convert_rest(const Params& p, float* ldsf, int first) {
  const int n = gridDim.x - first, me = blockIdx.x - first;
  if (me < 0) return;
  constexpr int NT0 = 16 * 88 / 2, NT1 = 44 * 16 / 2;
  for (int u = me; u < NT0 + NT1; u += n) {
    if (u < NT0) convert_pair(p, 8, u, ldsf);
    else convert_pair(p, 9, u - NT0, ldsf);
  }
}

template <int PASS>
DI void row_pass(const Params& p) {
  const int t512 = ltid(); const int lane = t512 & 63, wid = t512 >> 6;
  const int nrows = (PASS <= 2) ? TA : TL;
  const int gwave = blockIdx.x * NW + wid, nwaves = gridDim.x * NW;
  const int per = (nrows + nwaves - 1) / nwaves;
  const int rbeg = gwave * per, rend = min(rbeg + per, nrows);
  const float* ng = p.norm_g;
  const bf16_t* Y = p.big + ((PASS == 3) ? OFF_Y2 : OFF_Y);
  const float* ssq = p.ssq + ((PASS == 2) ? 0 : (PASS == 3) ? 3 * TA : 4 * TA);
  f32x4 cres[4], cmul[4], cadd[4];
  f32x4 xn[4]; u32x2 xbn[4]; u32x2 yn[4]; float sn = 0.f;
  int curb = -1;
  auto load_vecs = [&](int b) {
    curb = b;
      const float* mod = p.mod + (size_t)b * 9216;
#pragma unroll
      for (int i = 0; i < 4; ++i) {
        const int col = (i * 64 + lane) * 4;
        if (PASS >= 2) {
          const float* gpost = ng + ((PASS == 2) ? 1 : (PASS == 3) ? 3 : 5) * 1024;
          const float* gate = mod + ((PASS == 2) ? 2 : (PASS == 3) ? 5 : 8) * 1024;
          const float wgt = (PASS == 3) ? 1.0f : 0.5f;
          cres[i] = wgt * (*(const f32x4*)(gate + col)) * (*(const f32x4*)(gpost + col));
        }
        if (PASS <= 3) {
          const float* gpre = ng + ((PASS == 1) ? 0 : (PASS == 2) ? 2 : 4) * 1024;
          const float* shift = mod + ((PASS == 1) ? 0 : (PASS == 2) ? 3 : 6) * 1024;
          const float* scale = mod + ((PASS == 1) ? 1 : (PASS == 2) ? 4 : 7) * 1024;
          cmul[i] = (*(const f32x4*)(gpre + col)) * (1.f + *(const f32x4*)(scale + col));
          cadd[i] = *(const f32x4*)(shift + col);
        }
      }
  };
  const int rend_main = (PASS == 2) ? min(rend, TL) : rend;
  for (int row = rbeg; row < rend_main; ++row) {
    const int b = (row < TL) ? (row >> 11) : 16;
    if (b != curb) load_vecs(b);
    auto xload = [&](int r, f32x4 (&xf)[4], u32x2 (&xb)[4]) {
      if (PASS <= 2) {
        const float* s = (r < TL) ? p.x + (size_t)r * 1024 : p.ctx + (size_t)(r - TL) * 1024;
#pragma unroll
        for (int i = 0; i < 4; ++i) xf[i] = *(const f32x4*)(s + (i * 64 + lane) * 4);
      } else {
        const bf16_t* s = (const bf16_t*)(p.out + (size_t)r * 1024);
#pragma unroll
        for (int i = 0; i < 4; ++i) xb[i] = *(const u32x2*)(s + (i * 64 + lane) * 4);
      }
    };
    f32x4 xv[4]; u32x2 xbv[4]; u32x2 yw[4]; float sq = 0.f;
    if (row == rbeg) {
      xload(row, xv, xbv);
      if (PASS >= 2) {
        sq = ssq[row];
#pragma unroll
        for (int i = 0; i < 4; ++i) yw[i] = *(const u32x2*)(Y + (size_t)row * 1024 + (i * 64 + lane) * 4);
      }
    } else {
#pragma unroll
      for (int i = 0; i < 4; ++i) { xv[i] = xn[i]; xbv[i] = xbn[i]; yw[i] = yn[i]; }
      sq = sn;
    }
    if (row + 1 < rend_main) {
      const int nr = row + 1;
      xload(nr, xn, xbn);
      if (PASS >= 2) {
        sn = ssq[nr];
#pragma unroll
        for (int i = 0; i < 4; ++i) yn[i] = *(const u32x2*)(Y + (size_t)nr * 1024 + (i * 64 + lane) * 4);
      }
    }
    if (PASS >= 3) {
#pragma unroll
      for (int i = 0; i < 4; ++i) {
        const u32x2 w = xbv[i];
        xv[i] = (f32x4){__uint_as_float(w.x << 16), __uint_as_float(w.x & 0xffff0000u), __uint_as_float(w.y << 16), __uint_as_float(w.y & 0xffff0000u)};
      }
    }
    if (PASS >= 2) {
      const float rs = rsqrtf(sq * (1.f / 1024.f) + RMS_EPS);
#pragma unroll
      for (int i = 0; i < 4; ++i) {
        const int col = (i * 64 + lane) * 4;
        const u32x2 w = yw[i];
        const f32x4 yv = {__uint_as_float(w.x << 16), __uint_as_float(w.x & 0xffff0000u), __uint_as_float(w.y << 16), __uint_as_float(w.y & 0xffff0000u)};
        xv[i] = xv[i] + (yv * rs) * cres[i];
        if (PASS == 4) *(f32x4*)(p.out + (size_t)row * 1024 + col) = xv[i];
        else if (row < TL) store_bf16x4((bf16_t*)(p.out + (size_t)row * 1024) + col, xv[i]);
      }
    }
    if (PASS <= 3) {
      float s = 0.f;
#pragma unroll
      for (int i = 0; i < 4; ++i) s += xv[i][0] * xv[i][0] + xv[i][1] * xv[i][1] + xv[i][2] * xv[i][2] + xv[i][3] * xv[i][3];
      s = wave_sum(s);
      const float rs = rsqrtf(s * (1.f / 1024.f) + RMS_EPS);
#pragma unroll
      for (int i = 0; i < 4; ++i) {
        const int col = (i * 64 + lane) * 4;
        store_bf16x4(p.H + (size_t)row * 1024 + col, (xv[i] * rs) * cmul[i] + cadd[i]);
      }
    }
  }
  if (PASS == 2) {
    for (int row = max(rbeg, TL); row < rend; ++row) {
      if (curb != 16) load_vecs(16);
      const float* xs = p.ctx + (size_t)(row - TL) * 1024;
      const float* y0 = p.xc + (size_t)(row - TL) * 1024;
      const float* y1 = p.yc1 + (size_t)(row - TL) * 1024;
      f32x4 xv[4], yv[4];
#pragma unroll
      for (int i = 0; i < 4; ++i) {
        const int col = (i * 64 + lane) * 4;
        xv[i] = *(const f32x4*)(xs + col);
        yv[i] = *(const f32x4*)(y0 + col) + *(const f32x4*)(y1 + col);
      }
      float sy = 0.f;
#pragma unroll
      for (int i = 0; i < 4; ++i) sy += yv[i][0] * yv[i][0] + yv[i][1] * yv[i][1] + yv[i][2] * yv[i][2] + yv[i][3] * yv[i][3];
      sy = wave_sum(sy);
      const float rsy = rsqrtf(sy * (1.f / 1024.f) + RMS_EPS);
      float s = 0.f;
#pragma unroll
      for (int i = 0; i < 4; ++i) {
        xv[i] = xv[i] + (yv[i] * rsy) * cres[i];
        s += xv[i][0] * xv[i][0] + xv[i][1] * xv[i][1] + xv[i][2] * xv[i][2] + xv[i][3] * xv[i][3];
      }
      s = wave_sum(s);
      const float rs = rsqrtf(s * (1.f / 1024.f) + RMS_EPS);
#pragma unroll
      for (int i = 0; i < 4; ++i) {
        const int col = (i * 64 + lane) * 4;
        store_bf16x4(p.H + (size_t)row * 1024 + col, (xv[i] * rs) * cmul[i] + cadd[i]);
      }
    }
  }
}

DI void mla_unit(const Params& p, int unit, bf16_t* lds) {
  const int tid = ltid(), lane = tid & 63, wid = tid >> 6, fr = lane & 15, fq = lane >> 4;
  const int qb = unit & 7, h = (unit >> 3) & 7, b = unit >> 6;
  const bf16_t* QM = p.big + OFF_QM;
  const bf16_t* KV = p.H;
  const bf16_t* KR = p.big + OFF_KR;
  bf16_t* OM = p.big + OFF_OM;
  bf16_t* sK = lds;
  bf16_t* sV = lds + 2 * 64 * LDK;
  const int q0 = b * 2048 + qb * 256 + wid * 32;
  bf16x8 qf[2][3];
#pragma unroll
  for (int qt = 0; qt < 2; ++qt)
#pragma unroll
    for (int ks = 0; ks < 3; ++ks) qf[qt][ks] = *(const bf16x8*)(QM + (size_t)(q0 + qt * 16 + fr) * 768 + h * 96 + ks * 32 + fq * 8);

  const int kr0 = tid / 12, kc0 = tid - kr0 * 12;
  const int kr1 = (tid + 512) / 12, kc1 = (tid + 512) - kr1 * 12;
  const bool k2 = tid < 256;
  const int vrow = tid >> 3, vch = tid & 7;
  u32x4 rk0, rk1, rv;
  auto load_tile = [&](int kt) {
    const int kbase = kt * 64;
    const int rowbase = (kbase < 2048) ? (b * 2048 + kbase) : (TL + b * 256 + (kbase - 2048));
    {
      const size_t r = rowbase + kr0;
      rk0 = *(const u32x4*)((kc0 < 8) ? (KV + r * 1024 + h * 128 + kc0 * 8) : (KR + r * 32 + (kc0 - 8) * 8));
    }
    if (k2) {
      const size_t r = rowbase + kr1;
      rk1 = *(const u32x4*)((kc1 < 8) ? (KV + r * 1024 + h * 128 + kc1 * 8) : (KR + r * 32 + (kc1 - 8) * 8));
    }
    rv = *(const u32x4*)(KV + (size_t)(rowbase + vrow) * 1024 + h * 128 + 64 + vch * 8);
  };
  auto store_tile = [&](int buf) {
    *(u32x4*)(sK + buf * 64 * LDK + kr0 * LDK + kc0 * 8) = rk0;
    if (k2) *(u32x4*)(sK + buf * 64 * LDK + kr1 * LDK + kc1 * 8) = rk1;
    *(u32x4*)(sV + buf * 64 * LDV + vrow * LDV + vch * 8) = rv;
  };

  f32x4 o[4][2], lacc[2];
  float mref[2];
#pragma unroll
  for (int qt = 0; qt < 2; ++qt) {
    mref[qt] = 0.f; lacc[qt] = (f32x4){0.f, 0.f, 0.f, 0.f};
#pragma unroll
    for (int dt = 0; dt < 4; ++dt) o[dt][qt] = (f32x4){0.f, 0.f, 0.f, 0.f};
  }
  const bf16x8 ones = {(short)0x3F80, (short)0x3F80, (short)0x3F80, (short)0x3F80, (short)0x3F80, (short)0x3F80, (short)0x3F80, (short)0x3F80};
  load_tile(0);
  store_tile(0);
  __syncthreads();
  constexpr int NKT = 36;
  for (int kt = 0; kt < NKT; ++kt) {
    const int cur = kt & 1;
    const bool more = kt + 1 < NKT;
    if (more) load_tile(kt + 1);
    const bf16_t* cK = sK + cur * 64 * LDK;
    const bf16_t* cV = sV + cur * 64 * LDV;
    f32x4 s[4][2], sinit[2];
#pragma unroll
    for (int qt = 0; qt < 2; ++qt) { const float ni = -mref[qt]; sinit[qt] = (f32x4){ni, ni, ni, ni}; }
    bf16x8 kf[3][4];
#pragma unroll
    for (int ks = 0; ks < 3; ++ks)
#pragma unroll
      for (int t4 = 0; t4 < 4; ++t4) kf[ks][t4] = *(const bf16x8*)(cK + (t4 * 16 + fr) * LDK + ks * 32 + fq * 8);
#pragma unroll
    for (int ks = 0; ks < 3; ++ks)
#pragma unroll
      for (int t4 = 0; t4 < 4; ++t4)
#pragma unroll
        for (int qt = 0; qt < 2; ++qt) s[t4][qt] = mfma16(kf[ks][t4], qf[qt][ks], ks == 0 ? sinit[qt] : s[t4][qt]);
    s16x4 vlo[2][4], vhi[2][4];
#pragma unroll
    for (int s2 = 0; s2 < 2; ++s2)
#pragma unroll
      for (int dt = 0; dt < 4; ++dt) {
        const bf16_t* vp = cV + (s2 * 32 + 4 * fq + (fr >> 2)) * LDV + dt * 16 + 4 * (fr & 3);
        vlo[s2][dt] = tr_read(vp); vhi[s2][dt] = tr_read(vp + 16 * LDV);
      }
    __builtin_amdgcn_sched_barrier(0);
    float mx[2];
#pragma unroll
    for (int qt = 0; qt < 2; ++qt) {
      float v = fmaxf(fmaxf(s[0][qt][0], s[0][qt][1]), fmaxf(s[0][qt][2], s[0][qt][3]));
#pragma unroll
      for (int t4 = 1; t4 < 4; ++t4) v = fmaxf(v, fmaxf(fmaxf(s[t4][qt][0], s[t4][qt][1]), fmaxf(s[t4][qt][2], s[t4][qt][3])));
      v = fmaxf(v, __shfl_xor(v, 16)); v = fmaxf(v, __shfl_xor(v, 32));
      mx[qt] = v;
    }
    if (__any((kt == 0) || (mx[0] > 8.f) || (mx[1] > 8.f))) {
#pragma unroll
      for (int qt = 0; qt < 2; ++qt) {
        const float delta = (kt == 0) ? mx[qt] : fmaxf(mx[qt], 0.f);
        mref[qt] += delta;
        const float sc = __builtin_amdgcn_exp2f(-delta);
#pragma unroll
        for (int t4 = 0; t4 < 4; ++t4) s[t4][qt] = s[t4][qt] - delta;
#pragma unroll
        for (int dt = 0; dt < 4; ++dt) o[dt][qt] = o[dt][qt] * sc;
        lacc[qt] = lacc[qt] * sc;
      }
    }
    bf16x8 pf[2][2];
#pragma unroll
    for (int qt = 0; qt < 2; ++qt) {
#pragma unroll
      for (int t4 = 0; t4 < 4; ++t4)
#pragma unroll
        for (int j = 0; j < 4; ++j) s[t4][qt][j] = __builtin_amdgcn_exp2f(s[t4][qt][j]);
#pragma unroll
      for (int s2 = 0; s2 < 2; ++s2) {
        u32x4 w;
        w.x = pk_bf16(s[2 * s2][qt][0], s[2 * s2][qt][1]); w.y = pk_bf16(s[2 * s2][qt][2], s[2 * s2][qt][3]);
        w.z = pk_bf16(s[2 * s2 + 1][qt][0], s[2 * s2 + 1][qt][1]); w.w = pk_bf16(s[2 * s2 + 1][qt][2], s[2 * s2 + 1][qt][3]);
        pf[s2][qt] = __builtin_bit_cast(bf16x8, w);
      }
    }
#pragma unroll
    for (int s2 = 0; s2 < 2; ++s2) {
#pragma unroll
      for (int dt = 0; dt < 4; ++dt) {
        const bf16x8 vf = cat8(vlo[s2][dt], vhi[s2][dt]);
#pragma unroll
        for (int qt = 0; qt < 2; ++qt) o[dt][qt] = mfma16(vf, pf[s2][qt], o[dt][qt]);
      }
#pragma unroll
      for (int qt = 0; qt < 2; ++qt) lacc[qt] = mfma16(ones, pf[s2][qt], lacc[qt]);
    }
    if (more) store_tile(cur ^ 1);
    __syncthreads();
  }
#pragma unroll
  for (int qt = 0; qt < 2; ++qt) {
    const float inv = 1.f / lacc[qt][0];
#pragma unroll
    for (int dt = 0; dt < 4; ++dt) store_bf16x4(OM + (size_t)(q0 + qt * 16 + fr) * 512 + h * 64 + dt * 16 + 4 * fq, o[dt][qt] * inv);
  }
}

DI void na_unit(const Params& p, int unit, bf16_t* lds, float* srpb) {
  const int tid = ltid(), lane = tid & 63, wid = tid >> 6, j = wid & 3, fr = lane & 15, fq = lane >> 4;
  const int rp = unit & 15, h = (unit >> 4) & 7, b = unit >> 7;
  const int r = 2 * rp + (wid >> 2);
  const bf16_t* QA = p.big + OFF_QA;
  const bf16_t* KA = p.big + OFF_KA;
  const bf16_t* VA = p.big + OFF_VA;
  bf16_t* sVl = lds;
  bf16_t* sVc = lds + 576 * LDT;
  bf16_t* sKl = sVc;
  const int rs0 = min(max(2 * rp - 4, 0), 24);
  const int rs = min(max(r - 4, 0), 24);
  const int ks = min(max(16 * j - 8, 0), 32);
  bf16_t* sKc = lds + (256 + 576) * LDT;
#pragma unroll
  for (int i = 0; i < 4; ++i) {
    const int idx = tid + NT * i, row = idx >> 3, ch = idx & 7;
    *(u32x4*)(sVc + row * LDT + ch * 8) = *(const u32x4*)(VA + (size_t)(TL + b * 256 + row) * 512 + h * 64 + ch * 8);
    *(u32x4*)(sKc + row * LDT + ch * 8) = *(const u32x4*)(KA + (size_t)(TL + b * 256 + row) * 512 + h * 64 + ch * 8);
  }
  {
    u32x4 tv[9];
#pragma unroll
    for (int i = 0; i < 9; ++i) {
      const int idx = tid + NT * i, row = idx >> 3, ch = idx & 7;
      const size_t tok = (size_t)b * 2048 + (rs0 + (row >> 6)) * 64 + (row & 63);
      tv[i] = *(const u32x4*)(VA + tok * 512 + h * 64 + ch * 8);
    }
#pragma unroll
    for (int i = 0; i < 9; ++i) {
      const int idx = tid + NT * i, row = idx >> 3, ch = idx & 7;
      *(u32x4*)(sVl + row * LDT + ch * 8) = tv[i];
    }
  }
  u32x4 tk[9];
#pragma unroll
  for (int i = 0; i < 9; ++i) {
    const int idx = tid + NT * i, row = idx >> 3, ch = idx & 7;
    const size_t tok = (size_t)b * 2048 + (rs0 + (row >> 6)) * 64 + (row & 63);
    tk[i] = *(const u32x4*)(KA + tok * 512 + h * 64 + ch * 8);
  }
  if (tid < 465) srpb[tid] = p.rpb[h * 465 + tid] * LOG2E;
  const size_t qrow = (size_t)b * 2048 + r * 64 + 16 * j + fr;
  bf16x8 qf[2];
  qf[0] = *(const bf16x8*)(QA + qrow * 512 + h * 64 + fq * 8);
  qf[1] = *(const bf16x8*)(QA + qrow * 512 + h * 64 + 32 + fq * 8);
  f32x4 o[4], lacc = {0.f, 0.f, 0.f, 0.f};
#pragma unroll
  for (int dt = 0; dt < 4; ++dt) o[dt] = (f32x4){0.f, 0.f, 0.f, 0.f};
  float mref = 0.f;
  const int qc = 16 * j + fr;
  const int wst = min(max(qc - 8, 0), 48);
  const bf16x8 ones = {(short)0x3F80, (short)0x3F80, (short)0x3F80, (short)0x3F80, (short)0x3F80, (short)0x3F80, (short)0x3F80, (short)0x3F80};
  bf16x8 kf[4][2];
  auto load_k = [&](int ci) {
    if (ci < 4) {
#pragma unroll
      for (int t = 0; t < 4; ++t) {
        const bf16_t* kp = sKc + (ci * 64 + t * 16 + fr) * LDT + fq * 8;
        kf[t][0] = *(const bf16x8*)kp; kf[t][1] = *(const bf16x8*)(kp + 32);
      }
    } else {
      const int rbase = (rs - rs0 + 2 * (ci - 4)) * 64 + ks;
#pragma unroll
      for (int t = 0; t < 4; ++t) {
        const int rl = rbase + (t >> 1) * 64 + (t & 1) * 16 + fr;
        const bf16_t* kp = sKl + rl * 64;
        kf[t][0] = *(const bf16x8*)(kp + ((fq ^ (rl & 7)) * 8));
        kf[t][1] = *(const bf16x8*)(kp + (((4 + fq) ^ (rl & 7)) * 8));
      }
    }
  };
  int co8[2][4]; bool ok8[2][4];
#pragma unroll
  for (int e = 0; e < 2; ++e)
#pragma unroll
    for (int jj = 0; jj < 4; ++jj) {
      const int kc = ks + e * 16 + 4 * fq + jj;
      ok8[e][jj] = (kc >= wst) && (kc < wst + 16);
      co8[e][jj] = min(max(kc - qc, -15), 15) + 15;
    }
  __syncthreads();
  load_k(0);
#pragma unroll 1
  for (int ci = 0; ci < 8; ++ci) {
    const int half = ci >> 2, c = ci & 3;
    if (ci == 4) {
      __syncthreads();
#pragma unroll
      for (int i = 0; i < 9; ++i) {
        const int idx = tid + NT * i, row = idx >> 3, ch = idx & 7;
        *(u32x4*)(sKl + row * 64 + ((ch ^ (row & 7)) * 8)) = tk[i];
      }
      __syncthreads();
      load_k(4);
    }
    f32x4 s[4];
    const f32x4 sinit = {-mref, -mref, -mref, -mref};
#pragma unroll
    for (int t = 0; t < 4; ++t) {
      f32x4 a = mfma16(kf[t][0], qf[0], sinit);
      a = mfma16(kf[t][1], qf[1], a);
      s[t] = a;
    }
    if (ci < 7 && ci != 3) load_k(ci + 1);
    if (half == 1) {
      float bias[4][4];
#pragma unroll
      for (int t = 0; t < 4; ++t) {
        const int ro = (rs + 2 * c + (t >> 1) - r + 7) * 31;
#pragma unroll
        for (int jj = 0; jj < 4; ++jj) bias[t][jj] = srpb[ro + co8[t & 1][jj]];
      }
#pragma unroll
      for (int t = 0; t < 4; ++t)
#pragma unroll
        for (int jj = 0; jj < 4; ++jj) s[t][jj] = ok8[t & 1][jj] ? (s[t][jj] + bias[t][jj]) : -1e30f;
    }
    float mx = fmaxf(fmaxf(s[0][0], s[0][1]), fmaxf(s[0][2], s[0][3]));
#pragma unroll
    for (int t = 1; t < 4; ++t) mx = fmaxf(mx, fmaxf(fmaxf(s[t][0], s[t][1]), fmaxf(s[t][2], s[t][3])));
    mx = fmaxf(mx, __shfl_xor(mx, 16)); mx = fmaxf(mx, __shfl_xor(mx, 32));
    if (__any((ci == 0) || (mx > 8.f))) {
      const float delta = (ci == 0) ? mx : fmaxf(mx, 0.f);
      mref += delta;
      const float sc = __builtin_amdgcn_exp2f(-delta);
#pragma unroll
      for (int t = 0; t < 4; ++t) s[t] = s[t] - delta;
#pragma unroll
      for (int dt = 0; dt < 4; ++dt) o[dt] = o[dt] * sc;
      lacc = lacc * sc;
    }
#pragma unroll
    for (int s2 = 0; s2 < 2; ++s2) {
      f32x4 e0, e1;
#pragma unroll
      for (int jj = 0; jj < 4; ++jj) {
        e0[jj] = __builtin_amdgcn_exp2f(s[2 * s2][jj]);
        e1[jj] = __builtin_amdgcn_exp2f(s[2 * s2 + 1][jj]);
      }
      u32x4 w;
      w.x = pk_bf16(e0[0], e0[1]); w.y = pk_bf16(e0[2], e0[3]); w.z = pk_bf16(e1[0], e1[1]); w.w = pk_bf16(e1[2], e1[3]);
      const bf16x8 pf = __builtin_bit_cast(bf16x8, w);
      const bf16_t* vb = (half == 0) ? (sVc + (c * 64 + s2 * 32) * LDT) : (sVl + ((rs - rs0 + 2 * c + s2) * 64 + ks) * LDT);
#pragma unroll
      for (int dt = 0; dt < 4; ++dt) {
        const bf16_t* vp = vb + (4 * fq + (fr >> 2)) * LDT + dt * 16 + 4 * (fr & 3);
        const bf16x8 vf = cat8(tr_read(vp), tr_read(vp + 16 * LDT));
        o[dt] = mfma16(vf, pf, o[dt]);
      }
      lacc = mfma16(ones, pf, lacc);
    }
  }
  const float inv = 1.f / lacc[0];
#pragma unroll
  for (int dt = 0; dt < 4; ++dt) store_bf16x4(p.big + OFF_ON + qrow * 512 + h * 64 + dt * 16 + 4 * fq, o[dt] * inv);
  __syncthreads();
}

__global__ void __launch_bounds__(512) fwd_megakernel(Params p) {
  cg::grid_group grid = cg::this_grid();
  __shared__ __attribute__((aligned(16))) unsigned char lds_raw[LDS_BYTES];
  __shared__ float srpb[480];
  bf16_t* lds = (bf16_t*)lds_raw;
  float* ldsf = (float*)lds_raw;
  PG8_LAS unsigned char* glds = (PG8_LAS unsigned char*)lds_raw;
  const int G = gridDim.x, bid = blockIdx.x;
  using namespace pg8;
  __shared__ __attribute__((aligned(16))) unsigned xb_st[4];
  if (threadIdx.x < 4) xb_st[threadIdx.x] = 0u;
  __syncthreads();
  const XcdBarrier xb = xcd_barrier_post(p.bar, (volatile LAS unsigned*)xb_st);

  phase0(p, ldsf);
  if (p.never) grid.sync();
  xcd_barrier(xb);
  row_pass<1>(p);
  xcd_barrier(xb);
  { SubOrder S; S.init(TA / 256, 22, 0, 0, WGM_UP); gemm_phase(glds, Gemm{p.H, p.W13a, TA, 5632, 1024}, S, EpiSwiglu{p.big + OFF_U}); }
  { const int r = (TA / 256 * 22) % G; convert_w2a(p, ldsf, r); }
  xcd_barrier(xb);
  { SubOrder S; S.init(TL / 256, 4, 0, 0, WGM_N4); gemm_phase(glds, Gemm{p.big + OFF_U, p.W2a, TL, 1024, DFF}, S, EpiStoreSsq{p.big + OFF_Y, p.ssq + 0 * TA}); }
  { ShiftOrder S{TL / 256, 0, 64}; gemm_phase(glds, Gemm{p.big + OFF_U, p.W2a, TA, 1024, DFF / 2, DFF, DFF}, S, EpiStoreF32{p.xc, TL}); }
  { ShiftOrder S{TL / 256, 64, 64}; gemm_phase(glds, Gemm{p.big + OFF_U + DFF / 2, p.W2a + DFF / 2, TA, 1024, DFF / 2, DFF, DFF}, S, EpiStoreF32{p.yc1, TL}); }
  convert_rest(p, ldsf, 128 < G ? 128 : 0);
  xcd_barrier(xb);
  row_pass<2>(p);
  xcd_barrier(xb);
  { ProjOrder S; S.init(); gemm_phase(glds, Gemm{p.H, p.Win, TA, NPROJP, 1024}, S, EpiProj{p.big, p.b_gate, p.ropecs, p.ssq + 1 * TA, p.ssq + 2 * TA}); }
  xcd_barrier(xb);
  { SubOrder S; S.init(TL / 256, 3, 0, 0, WGM_N4); gemm_phase(glds, Gemm{p.big + OFF_CQ, p.Wuq, TL, 768, 768}, S, EpiQup{p.big + OFF_QM, p.ssq + 1 * TA, p.ropecs}); }
  { KvOrder S; gemm_phase(glds, Gemm{p.big + OFF_CKV, p.Wukv, TA, 1024, 256}, S, EpiKVup{p.H, p.ssq + 2 * TA}); }
  xcd_barrier(xb);
  {
    const int xcd = bid & 7, loc = bid >> 3, per = G >> 3;
    for (int i = 0; (i * 8 + xcd) * per + loc < 1024; ++i) mla_unit(p, (i * 8 + xcd) * per + loc, lds);
    for (int i = 0; (i * 8 + xcd) * per + loc < 2048; ++i) na_unit(p, (i * 8 + xcd) * per + loc, lds, srpb);
  }
  xcd_barrier(xb);
  { SubOrder S; S.init(TL / 256, 4, 0, 0, WGM_N4); gemm_phase(glds, Gemm{p.big + OFF_ON, p.Wona, TL, 1024, 512}, S, EpiGate<false>{p.H, p.big + OFF_G, 0}); }
  { SubOrder S; S.init(TL / 256, 4, 0, 0, WGM_N4); gemm_phase(glds, Gemm{p.big + OFF_OM, p.Womla, TL, 1024, 512}, S, EpiGate<true>{p.H, p.big + OFF_G, 1024}); }
  xcd_barrier(xb);
  { SubOrder S; S.init(TL / 256, 4, 0, 0, WGM_N4); gemm_phase(glds, Gemm{p.H, p.Wout, TL, 1024, 1024}, S, EpiStoreSsq{p.big + OFF_Y2, p.ssq + 3 * TA}); }
  xcd_barrier(xb);
  row_pass<3>(p);
  xcd_barrier(xb);
  { SubOrder S; S.init(TL / 256, 22, 0, 0, WGM_UP); gemm_phase(glds, Gemm{p.H, p.W13b, TL, 5632, 1024}, S, EpiSwiglu{p.big + OFF_U}); }
  xcd_barrier(xb);
  { SubOrder S; S.init(TL / 256, 4, 0, 0, WGM_N4); gemm_phase(glds, Gemm{p.big + OFF_U, p.W2b, TL, 1024, DFF}, S, EpiStoreSsq{p.big + OFF_Y, p.ssq + 4 * TA}); }
  xcd_barrier(xb);
  row_pass<4>(p);
}

extern "C" void kernel_launch(void* const* d_in, const int* in_sizes, int n_in, void* d_out, int out_size, void* d_ws, size_t ws_size,
                              hipStream_t stream) {
  static int grid_blocks = 0;
  if (!grid_blocks) {
    int dev = 0, cus = 0, per_cu = 0;
    (void)hipGetDevice(&dev);
    (void)hipDeviceGetAttribute(&cus, hipDeviceAttributeMultiprocessorCount, dev);
    (void)hipOccupancyMaxActiveBlocksPerMultiprocessor(&per_cu, fwd_megakernel, NT, 0);
    if (per_cu > 1) per_cu = 1;
    grid_blocks = (cus * per_cu) & ~7;
  }
  Params p{};
  const float* const* in = (const float* const*)d_in;
  p.x = in[0]; p.c = in[1]; p.ctx = in[2]; p.c_ctx = in[3]; p.w_ada = in[4]; p.b_ada = in[5]; p.norm_g = in[6];
  p.f1w1 = in[7]; p.f1w3 = in[8]; p.f1w2 = in[9]; p.w_in = in[10]; p.b_gate = in[11]; p.g_q = in[12]; p.g_kv = in[13];
  p.w_uq = in[14]; p.w_ukv = in[15]; p.rpb = in[16]; p.w_o_na = in[17]; p.w_o_mla = in[18]; p.w_out = in[19];
  p.f2w1 = in[20]; p.f2w3 = in[21]; p.f2w2 = in[22];
  p.out = (float*)d_out;
  unsigned char* ws = (unsigned char*)d_ws;
  size_t off = 0;
  auto take = [&](size_t bytes) { size_t o = off; off += (bytes + 255) & ~(size_t)255; return ws + o; };
  p.bar = (unsigned*)take((size_t)XCD_BAR_WORDS * 4);
  p.mod = (float*)take((size_t)17 * 9216 * 4);
  p.ropecs = (float*)take(1024 * 4);
  p.ssq = (float*)take((size_t)5 * TA * 4);
  p.W13a = (bf16_t*)take((size_t)5632 * 1024 * 2);
  p.W2a = (bf16_t*)take((size_t)1024 * DFF * 2);
  p.Win = (bf16_t*)take((size_t)NPROJP * 1024 * 2);
  p.Wuq = (bf16_t*)take((size_t)768 * 768 * 2);
  p.Wukv = (bf16_t*)take((size_t)1024 * 256 * 2);
  p.Wona = (bf16_t*)take((size_t)1024 * 512 * 2);
  p.Womla = (bf16_t*)take((size_t)1024 * 512 * 2);
  p.Wout = (bf16_t*)take((size_t)1024 * 1024 * 2);
  p.W13b = (bf16_t*)take((size_t)5632 * 1024 * 2);
  p.W2b = (bf16_t*)take((size_t)1024 * DFF * 2);
  p.xc = (float*)take((size_t)TC * 1024 * 4);
  p.yc1 = (float*)take((size_t)TC * 1024 * 4);
  p.H = (bf16_t*)take((size_t)TA * 1024 * 2);
  p.big = (bf16_t*)take(BIG_ELEMS * 2);
  if (off > ws_size) { fprintf(stderr, "workspace too small: need %zu have %zu\n", off, ws_size); return; }
  (void)hipMemsetAsync(p.bar, 0, (size_t)XCD_BAR_WORDS * 4, stream);
  void* args[] = {&p};
  hipError_t e = hipLaunchCooperativeKernel((void*)fwd_megakernel, dim3(grid_blocks), dim3(NT), args, 0, stream);
  if (e != hipSuccess) fprintf(stderr, "cooperative launch failed: %s (grid %d)\n", hipGetErrorString(e), grid_blocks);
}
```
